# Optimizing an MI355X kernel written in HIP

```python
import math
import jax, jax.numpy as jnp
from jax import lax
import numpy as np

D_MODEL = 2048
BATCH = 2
SEQ = 16384
DEPTH = 1

CHUNK = 64
QBLOCK = 128
ATT_HEADS = 8
ATT_HEAD_DIM = 128
ATT_WIDTH = ATT_HEADS * ATT_HEAD_DIM
IDX_HEADS = 16
IDX_DIM = 64
MAX_TOPK = 256
CONV_WIDTH = 1024
CONV_K = 3
REL_BUCKETS = 32
REL_MAX_DIST = 128
N_EXPERTS = 32
TOP_K_EXPERTS = 4
D_FF = D_MODEL
SWIGLU_LIMIT = 7.0
SWIGLU_ALPHA = 1.702
EXPERT_BLOCK = 256
PLE_DIM = 256
LN_EPS = 1e-5
DEEPNORM_ALPHA = (2 * DEPTH) ** 0.25
DEEPNORM_BETA = (8 * DEPTH) ** -0.25

IN_SPLITS = [ATT_WIDTH, ATT_WIDTH, ATT_WIDTH, IDX_HEADS * IDX_DIM, IDX_DIM, IDX_HEADS,
             CONV_WIDTH, CONV_WIDTH, CONV_WIDTH, D_MODEL, D_MODEL]
IN_COLS = sum(IN_SPLITS)
SPLIT_POINTS = [int(v) for v in np.cumsum(IN_SPLITS)[:-1]]

kernel_name = 'hybrid_dsa_shortconv_moe_block'


def layer_norm(x, g, b):
    xf = x.astype(jnp.float32)
    mu = jnp.mean(xf, axis=-1, keepdims=True)
    xc = xf - mu
    var = jnp.mean(xc * xc, axis=-1, keepdims=True)
    y = xc * lax.rsqrt(var + LN_EPS) * g.astype(jnp.float32) + b.astype(jnp.float32)
    return y.astype(x.dtype)


def t5_bucket(rel):
    half = REL_BUCKETS // 2
    max_exact = half // 2
    ret = jnp.where(rel > 0, half, 0)
    n = jnp.abs(rel)
    nf = jnp.maximum(n, 1).astype(jnp.float32)
    large = max_exact + (jnp.log(nf / max_exact) / math.log(REL_MAX_DIST / max_exact)
                         * (half - max_exact)).astype(jnp.int32)
    large = jnp.minimum(large, half - 1)
    return ret + jnp.where(n < max_exact, n, large)


def sparse_attention(q, k, v, qi, ki, wi, rel_bias):
    bsz, seq = q.shape[0], q.shape[1]
    topk = min(MAX_TOPK, seq // 4)
    nblk = seq // QBLOCK
    key_pos = jnp.arange(seq, dtype=jnp.int32)
    bidx = jnp.arange(bsz)[:, None, None]
    scale = ATT_HEAD_DIM ** -0.5

    def to_blocks(a):
        return jnp.moveaxis(a.reshape((bsz, nblk, QBLOCK) + a.shape[2:]), 1, 0)

    def block(args):
        blk, qb, qib, wib = args
        t = blk * QBLOCK + jnp.arange(QBLOCK, dtype=jnp.int32)
        limit = (t // CHUNK + 1) * CHUNK
        visible = key_pos[None, :] < limit[:, None]
        idx_logit = jnp.einsum('bqhd,bsd->bqhs', qib, ki)
        idx_score = jnp.einsum('bqhs,bqh->bqs', jax.nn.relu(idx_logit), wib).astype(jnp.float32)
        idx_score = jnp.where(visible[None], idx_score, -jnp.inf)
        _, sel = lax.top_k(idx_score, topk)
        sel_valid = sel < limit[None, :, None]
        kg = k[bidx, sel]
        vg = v[bidx, sel]
        bias = rel_bias[t5_bucket(sel - t[None, :, None])]
        logits = (jnp.einsum('bqhd,bqkhd->bqhk', qb, kg).astype(jnp.float32) * scale
                  + jnp.transpose(bias, (0, 1, 3, 2)).astype(jnp.float32))
        logits = jnp.where(sel_valid[:, :, None, :], logits, -1e30)
        probs = jax.nn.softmax(logits, axis=-1).astype(vg.dtype)
        o = jnp.einsum('bqhk,bqkhd->bqhd', probs, vg)
        return o.reshape(bsz, QBLOCK, ATT_WIDTH)

    out = lax.map(block, (jnp.arange(nblk, dtype=jnp.int32), to_blocks(q), to_blocks(qi), to_blocks(wi)))
    return jnp.moveaxis(out, 0, 1).reshape(bsz, seq, ATT_WIDTH)


def short_gated_conv(gate_b, gate_c, u, conv_w):
    cu = gate_c * u
    y = lax.conv_general_dilated(cu, conv_w[:, None, :], window_strides=(1,),
                                 padding=[(CONV_K - 1, 0)],
                                 dimension_numbers=('NWC', 'WIO', 'NWC'),
                                 feature_group_count=CONV_WIDTH)
    return gate_b * y


def token_mixers(h, w_in, conv_w, rel_bias, w_att_br, w_conv_br, w_o):
    bsz, seq, _ = h.shape
    z = h @ w_in
    q, k, v, qi, ki, wi, gb, gc, u, ga, gcv = jnp.split(z, SPLIT_POINTS, axis=-1)
    hd = (bsz, seq, ATT_HEADS, ATT_HEAD_DIM)
    att = sparse_attention(q.reshape(hd), k.reshape(hd), v.reshape(hd),
                           qi.reshape(bsz, seq, IDX_HEADS, IDX_DIM), ki, wi, rel_bias)
    conv = short_gated_conv(gb, gc, u, conv_w)
    merged = jax.nn.sigmoid(ga) * (att @ w_att_br) + jax.nn.sigmoid(gcv) * (conv @ w_conv_br)
    return merged @ w_o


def moe(h, w_router, b_router, w_gate, b_gate, w_up, b_up, w_down, b_down):
    bsz, seq, d = h.shape
    n_tok = bsz * seq
    n_assign = n_tok * TOP_K_EXPERTS
    xf = h.reshape(n_tok, d)
    logits = (xf @ w_router + b_router).astype(jnp.float32)
    top_v, top_e = lax.top_k(logits, TOP_K_EXPERTS)
    gates = jax.nn.softmax(top_v, axis=-1)
    e_flat = top_e.reshape(-1)
    tok_flat = jnp.repeat(jnp.arange(n_tok, dtype=jnp.int32), TOP_K_EXPERTS)
    g_flat = gates.reshape(-1)
    order = jnp.argsort(e_flat)
    e_sorted = e_flat[order]
    counts = jnp.bincount(e_flat, length=N_EXPERTS)
    starts = jnp.cumsum(counts) - counts
    padded = (counts + EXPERT_BLOCK - 1) // EXPERT_BLOCK * EXPERT_BLOCK
    pends = jnp.cumsum(padded)
    pstarts = pends - padded
    dest = pstarts[e_sorted] + (jnp.arange(n_assign) - starts[e_sorted])
    n_blocks = (n_assign + N_EXPERTS * (EXPERT_BLOCK - 1) + EXPERT_BLOCK - 1) // EXPERT_BLOCK
    n_rows = n_blocks * EXPERT_BLOCK
    row_tok = jnp.zeros((n_rows,), jnp.int32).at[dest].set(tok_flat[order])
    row_w = jnp.zeros((n_rows,), jnp.float32).at[dest].set(g_flat[order])
    block_start = jnp.arange(n_blocks) * EXPERT_BLOCK
    block_e = jnp.minimum(jnp.searchsorted(pends, block_start, side='right'), N_EXPERTS - 1)

    def step(y, blk):
        tok, wt, e = blk
        xb = xf[tok]
        g = xb @ w_gate[e] + b_gate[e]
        u = xb @ w_up[e] + b_up[e]
        g = jnp.minimum(g, SWIGLU_LIMIT)
        u = jnp.clip(u, -SWIGLU_LIMIT, SWIGLU_LIMIT)
        a = (u + 1.0) * (g * jax.nn.sigmoid(SWIGLU_ALPHA * g))
        o = a @ w_down[e] + b_down[e]
        return y.at[tok].add(o * wt.astype(o.dtype)[:, None]), None

    y, _ = lax.scan(step, jnp.zeros_like(xf),
                    (row_tok.reshape(n_blocks, EXPERT_BLOCK),
                     row_w.reshape(n_blocks, EXPERT_BLOCK), block_e))
    return y.reshape(bsz, seq, d)


def setup_inputs(seed: int = 0) -> dict:
    key = jax.random.key(seed)
    ks = jax.random.split(key, 32)
    L, D, E, F = DEPTH, D_MODEL, N_EXPERTS, D_FF

    def nrm(k, shape, scale):
        return jax.random.normal(k, shape, jnp.float32) * scale

    return {
        'x': nrm(ks[0], (BATCH, SEQ, D), 1.0),
        'p': nrm(ks[1], (DEPTH, BATCH, SEQ, PLE_DIM), 1.0),
        'ln_in_g': 1.0 + nrm(ks[2], (D,), 0.02),
        'ln_in_b': nrm(ks[3], (D,), 0.02),
        'rel_bias': nrm(ks[4], (REL_BUCKETS, ATT_HEADS), 0.5),
        'w_in': nrm(ks[5], (L, D, IN_COLS), D ** -0.5),
        'conv_w': nrm(ks[6], (L, CONV_K, CONV_WIDTH), CONV_K ** -0.5),
        'w_att_br': nrm(ks[7], (L, ATT_WIDTH, D), ATT_WIDTH ** -0.5 * DEEPNORM_BETA),
        'w_conv_br': nrm(ks[8], (L, CONV_WIDTH, D), CONV_WIDTH ** -0.5 * DEEPNORM_BETA),
        'w_o': nrm(ks[9], (L, D, D), D ** -0.5 * DEEPNORM_BETA),
        'ln1_g': 1.0 + nrm(ks[10], (L, D), 0.02),
        'ln1_b': nrm(ks[11], (L, D), 0.02),
        'w_router': nrm(ks[12], (L, D, E), D ** -0.5),
        'b_router': nrm(ks[13], (L, E), 0.01),
        'w_gate': nrm(ks[14], (L, E, D, F), D ** -0.5),
        'b_gate': nrm(ks[15], (L, E, F), 0.01),
        'w_up': nrm(ks[16], (L, E, D, F), D ** -0.5),
        'b_up': nrm(ks[17], (L, E, F), 0.01),
        'w_down': nrm(ks[18], (L, E, F, D), F ** -0.5 * DEEPNORM_BETA),
        'b_down': nrm(ks[19], (L, E, D), 0.01),
        'w_ple_gate': nrm(ks[20], (L, D, D), D ** -0.5),
        'w_ple_proj': nrm(ks[21], (L, PLE_DIM, D), PLE_DIM ** -0.5),
        'ln2_g': 1.0 + nrm(ks[22], (L, D), 0.02),
        'ln2_b': nrm(ks[23], (L, D), 0.02),
    }


def reference(x, p, ln_in_g, ln_in_b, rel_bias, w_in, conv_w, w_att_br, w_conv_br, w_o,
              ln1_g, ln1_b, w_router, b_router, w_gate, b_gate, w_up, b_up, w_down, b_down,
              w_ple_gate, w_ple_proj, ln2_g, ln2_b):
    h = layer_norm(x, ln_in_g, ln_in_b)
    for i in range(DEPTH):
        mix = token_mixers(h, w_in[i], conv_w[i], rel_bias, w_att_br[i], w_conv_br[i], w_o[i])
        h = layer_norm(DEEPNORM_ALPHA * h + mix, ln1_g[i], ln1_b[i])
        ff = moe(h, w_router[i], b_router[i], w_gate[i], b_gate[i], w_up[i], b_up[i],
                 w_down[i], b_down[i])
        ple = jax.nn.sigmoid(h @ w_ple_gate[i]) * (p[i] @ w_ple_proj[i])
        h = layer_norm(DEEPNORM_ALPHA * h + ff + ple, ln2_g[i], ln2_b[i])
    return h
```

```cpp
#include <hip/hip_runtime.h>
#include <cstdio>
#include <cstdint>

#define GAS __attribute__((address_space(1)))
#define LAS __attribute__((address_space(3)))
typedef unsigned short bf16_t;
typedef short bf16x8 __attribute__((ext_vector_type(8)));
typedef short s16x4 __attribute__((ext_vector_type(4)));
typedef short s16x2 __attribute__((ext_vector_type(2)));
typedef float f32x2 __attribute__((ext_vector_type(2)));
typedef float f32x4 __attribute__((ext_vector_type(4)));
typedef float f32x16 __attribute__((ext_vector_type(16)));
typedef unsigned u32x2 __attribute__((ext_vector_type(2)));
typedef unsigned u32x4 __attribute__((ext_vector_type(4)));
typedef int i32x4 __attribute__((ext_vector_type(4)));
typedef int i32x8 __attribute__((ext_vector_type(8)));

constexpr int M = 32768, D = 2048, SEQ = 16384, NBATCH = 2;
constexpr int IN_COLS = 11344, NIN_TILES = 45, NIN_PAD = NIN_TILES * 256;
constexpr int NEXP = 32, NROWS_MAX = 139264  , NBLK_MAX = 544;
constexpr float LN_EPS = 1e-5f;
constexpr float DN_ALPHA = 1.189207115002721f;
constexpr float ATT_SCALE = 0.08838834764831845f;
constexpr int NWAVES = 8, NTHR = 512, GRID = 256;

constexpr size_t MiB = 1u << 20;
constexpr size_t WS_CTL = 0, CTL_ZERO_BYTES = 1 * MiB;
constexpr size_t WS_STATS = 1 * MiB;
constexpr size_t WS_WVCNT = WS_STATS + 256 * 1024;
constexpr size_t WS_EXPINFO = WS_WVCNT + 256 * 1024;
constexpr size_t WS_LOGITS = 2 * MiB;
constexpr size_t WS_TOPE = 6 * MiB;
constexpr size_t WS_TOPG = 6 * MiB + 512 * 1024;
constexpr size_t WS_SLOT = 7 * MiB;
constexpr size_t WS_ROWTOK = 7 * MiB + 512 * 1024;
constexpr size_t WS_ROWW = 8 * MiB + 256 * 1024;
constexpr size_t WS_WA = 10 * MiB, WS_WB = 14 * MiB, WS_WO = 18 * MiB, WS_WPG = 26 * MiB, WS_WPP = 34 * MiB;
constexpr size_t WS_PB = 35 * MiB;
constexpr size_t WS_WIN = 51 * MiB;
constexpr size_t WS_HB = 96 * MiB;
constexpr size_t WS_ATT = 96 * MiB;
constexpr size_t WS_PLE = 96 * MiB;
constexpr size_t WS_Q = 224 * MiB, WS_K = 288 * MiB, WS_V = 352 * MiB;
constexpr size_t WS_QI = 416 * MiB;
constexpr size_t WS_KI = 480 * MiB;
constexpr size_t WS_WI = 484 * MiB;
constexpr size_t WS_GB = 488 * MiB;
constexpr size_t WS_CU = 552 * MiB;
constexpr size_t WS_SGA = 616 * MiB, WS_SGB = 744 * MiB;
constexpr size_t WS_SC = 872 * MiB;
constexpr size_t WS_MASK = 1392 * MiB;
constexpr size_t WS_T2 = 1456 * MiB;
constexpr size_t WS_Y1 = 1024 * MiB;
constexpr size_t WS_H1B = 1584 * MiB;
constexpr size_t WS_H1L = 1712 * MiB;
constexpr size_t WS_H1F = 1840 * MiB;
constexpr size_t WS_HB8 = 1840 * MiB;
constexpr size_t WS_WIN8 = 1904 * MiB;
#ifndef WIN8_LO_V
#define WIN8_LO_V 12
#define WIN8_HI_V 12
#endif
constexpr int WIN8_LO = WIN8_LO_V, WIN8_HI = WIN8_HI_V;
__host__ __device__ constexpr bool win_tile_f8(int pn) { return pn < WIN8_LO || pn >= WIN8_HI; }
constexpr size_t WS_GB8 = 1928 * MiB;
constexpr size_t WS_WRH = 9 * MiB, WS_WRL = 9 * MiB + 128 * 1024;
constexpr size_t WS_W1 = 224 * MiB;
constexpr size_t WS_W2 = 768 * MiB;
constexpr size_t WS_ACT = 1024 * MiB;
constexpr size_t WS_OW = 224 * MiB;
constexpr size_t WS_END = 1968 * MiB;
constexpr size_t SC_BATCH = 134742016;

constexpr int CW_TMO = 0, CW_BAR = 4096;

constexpr int STAGE_BYTES_C = 131072;
constexpr int ROWTAB_OFF = 131072;
constexpr int UNITE_OFF = 148480;
constexpr int MISC_OFF = 148736;
constexpr int LDS_BYTES = 149504;

#define LDS_WAIT() asm volatile("s_waitcnt lgkmcnt(0)" ::: "memory")
#define VM_WAIT() asm volatile("s_waitcnt vmcnt(0)" ::: "memory")
#define RLX_AGENT __ATOMIC_RELAXED, __HIP_MEMORY_SCOPE_AGENT

__device__ __forceinline__ unsigned f2bf(float f) { unsigned u = __builtin_bit_cast(unsigned, f); return (u + 0x7fffu + ((u >> 16) & 1u)) >> 16; }
__device__ __forceinline__ unsigned cvt_pk_bf16(float lo, float hi) { unsigned r; asm volatile("v_cvt_pk_bf16_f32 %0, %1, %2" : "=v"(r) : "v"(lo), "v"(hi)); return r; }
__device__ __forceinline__ unsigned pk2(float lo, float hi) { unsigned r; asm("v_cvt_pk_bf16_f32 %0, %1, %2" : "=v"(r) : "v"(lo), "v"(hi)); return r; }
__device__ __forceinline__ float bf_lo(unsigned w) { return __builtin_bit_cast(float, w << 16); }
__device__ __forceinline__ float bf_hi(unsigned w) { return __builtin_bit_cast(float, w & 0xffff0000u); }
constexpr float QKV8_SCALE = 8.f, GB8_SCALE = 4.f;
__host__ __device__ constexpr int vt_pos(int u) { return 32 * ((u >> 2) & 1) + 16 * (u >> 5) + (u & 3) + 4 * ((u & 31) >> 3); }
constexpr float W8_SCALE = 512.f, ACT8_H1 = 8.f, ACT8_A = 4.f, OW8_SCALE = 32.f;
typedef float f32x2_t __attribute__((ext_vector_type(2)));
__device__ __forceinline__ float sat8(float x) { return __builtin_amdgcn_fmed3f(x, -448.f, 448.f); }
__device__ __forceinline__ unsigned pk4_fp8(float a, float b, float c, float d) { int r = __builtin_amdgcn_cvt_pk_fp8_f32(a, b, 0, false); r = __builtin_amdgcn_cvt_pk_fp8_f32(c, d, r, true); return (unsigned)r; }
__device__ __forceinline__ float fast_sigmoid(float x) { return __builtin_amdgcn_rcpf(1.0f + __builtin_amdgcn_exp2f(-1.4426950408889634f * x)); }
__device__ __forceinline__ float wave_sum(float v) {
#pragma unroll
    for (int o = 1; o < 64; o <<= 1) v += __shfl_xor(v, o);
    return v;
}

#define XB_TMO      128
#define XB_XCNT(j)  (256  + 64 * (j))
#define XB_XSUB(j)  (1280 + 64 * (j))
#define XB_XGEN(j)  (2304 + 64 * (j))
#define XB_TOP      3328
#define XB_TOPGEN   3392
#define XCD_BAR_WORDS 3456
#define XB_SPIN_CAP (1u << 18)

__device__ __forceinline__ unsigned xb_ld(unsigned* p)              { return __hip_atomic_load(p, __ATOMIC_RELAXED, __HIP_MEMORY_SCOPE_AGENT); }
__device__ __forceinline__ unsigned xb_add(unsigned* p, unsigned v) { return __hip_atomic_fetch_add(p, v, __ATOMIC_RELAXED, __HIP_MEMORY_SCOPE_AGENT); }
__device__ __forceinline__ unsigned xb_xcc_id() { return (unsigned)__builtin_amdgcn_s_getreg((3 << 11) | 20) & 0xFu; }
#define XB_SPIN(cond, bar) do { unsigned _sp = 0; while (cond) { __builtin_amdgcn_s_sleep(1); \
    if ((++_sp & 255u) == 0u) { if (xb_ld(&(bar)[XB_TMO])) break; if (_sp > XB_SPIN_CAP) { atomicAdd(&(bar)[XB_TMO], 1u); break; } } } } while (0)

struct XcdBarrier { unsigned* bar; unsigned x; volatile LAS unsigned* st; };

__device__ __forceinline__ XcdBarrier xcd_barrier_post(unsigned* bar, volatile LAS unsigned* st) {
    XcdBarrier b; b.bar = bar; b.x = xb_xcc_id(); b.st = st;
    if (threadIdx.x == 0) (void)xb_add(&bar[XB_XCNT(b.x)], 1u);
    return b;
}
__device__ __forceinline__ void xcd_barrier_complete(unsigned* bar, unsigned x, unsigned& nloc, unsigned& nx) {
    const unsigned G = gridDim.x * gridDim.y * gridDim.z;
    unsigned sum, cnt, mine, sp = 0u;
    for (;;) {
        sum = 0u; cnt = 0u; mine = 0u;
#pragma unroll
        for (unsigned j = 0; j < 16; ++j) { const unsigned c = xb_ld(&bar[XB_XCNT(j)]); sum += c; cnt += (c > 0u) ? 1u : 0u; mine = (j == x) ? c : mine; }
        if (sum == G) break;
        __builtin_amdgcn_s_sleep(1);
        if ((++sp & 255u) == 0u) { if (xb_ld(&bar[XB_TMO])) break; if (sp > XB_SPIN_CAP) { atomicAdd(&bar[XB_TMO], 1u); break; } }
    }
    nloc = mine > 0u ? mine : 1u; nx = cnt > 0u ? cnt : 1u;
}
__device__ __forceinline__ void xcd_barrier(const XcdBarrier& b) {
    asm volatile("s_waitcnt vmcnt(0)" ::: "memory");
    __syncthreads();
    if (threadIdx.x == 0) {
        unsigned* bar = b.bar;
        __builtin_amdgcn_s_waitcnt(0);
        unsigned nloc = b.st[0], nx = b.st[1];
        if (nloc == 0u) { xcd_barrier_complete(bar, b.x, nloc, nx); b.st[0] = nloc; b.st[1] = nx; }
        const unsigned old = xb_add(&bar[XB_XSUB(b.x)], 1u);
        const unsigned gen = old / nloc;
        if (old + 1u == (gen + 1u) * nloc) {
            __builtin_amdgcn_fence(__ATOMIC_RELEASE, "agent");
            asm volatile("s_waitcnt vmcnt(0)" ::: "memory");
            const unsigned og = xb_add(&bar[XB_TOP], 1u);
            const unsigned tg = og / nx;
            if (og + 1u == (tg + 1u) * nx) xb_add(&bar[XB_TOPGEN], 1u);
            else XB_SPIN(xb_ld(&bar[XB_TOPGEN]) == tg, bar);
            __builtin_amdgcn_fence(__ATOMIC_ACQUIRE, "agent");
            xb_add(&bar[XB_XGEN(b.x)], 1u);
            asm volatile("s_waitcnt vmcnt(0)" ::: "memory");
        } else {
            XB_SPIN(xb_ld(&bar[XB_XGEN(b.x)]) == gen, bar);
            __builtin_amdgcn_fence(__ATOMIC_ACQUIRE, "agent");
            asm volatile("s_waitcnt vmcnt(0)" ::: "memory");
        }
    }
    __syncthreads();
}
namespace pg8 {
constexpr int BM = 256, BK = 64, HALF = 128, HTB = HALF * BK * 2, STAGE_BYTES = 8 * HTB, NXCD = 8;
__host__ __device__ __forceinline__ int lds_byte(int r, int c) { const int st = (r >> 4) * 2 + (c >> 5), rr = r & 15, cc = c & 31, ob = rr * 64 + cc * 2; return st * 1024 + (ob ^ (((ob >> 9) & 1) << 5)); }
__host__ __device__ __forceinline__ void stage_rc(int b, int& R, int& C) { const int st = b / 1024, sb = b % 1024, swz = sb ^ (((sb >> 9) & 1) << 5); R = (st >> 1) * 16 + swz / 64; C = (st & 1) * 32 + (swz % 64) / 2; }
__host__ __device__ __forceinline__ int perm32(int rho) { const int n = rho >> 4, i = rho & 15; return 8 * (i >> 2) + 4 * n + (i & 3); }

struct Unit { int pm, pn; };
template <bool F8> struct Frag;
template <> struct Frag<false> { bf16x8 v[2]; };
template <> struct Frag<true> { i32x8 v; };
__device__ __forceinline__ void ldfrag(Frag<false>& f, const LAS unsigned char* p) { f.v[0] = *(const LAS bf16x8*)p; f.v[1] = *(const LAS bf16x8*)(p + 1024); }
__device__ __forceinline__ void ldfrag(Frag<true>& f, const LAS unsigned char* p) { const i32x4 lo = *(const LAS i32x4*)p, hi = *(const LAS i32x4*)(p + 1024); f.v = __builtin_shufflevector(lo, hi, 0, 1, 2, 3, 4, 5, 6, 7); }
__device__ __forceinline__ f32x4 mma(const Frag<false>& b, const Frag<false>& a, f32x4 c) { c = __builtin_amdgcn_mfma_f32_16x16x32_bf16(b.v[0], a.v[0], c, 0, 0, 0); return __builtin_amdgcn_mfma_f32_16x16x32_bf16(b.v[1], a.v[1], c, 0, 0, 0); }
__device__ __forceinline__ f32x4 mma(const Frag<true>& b, const Frag<true>& a, f32x4 c) { asm volatile("v_mfma_f32_16x16x128_f8f6f4 %0, %1, %2, %0" : "+v"(c) : "v"(b.v), "v"(a.v)); return c; }

struct StaticOrder {
    int nM, nN, nwg, G, c, WGM;
    __device__ __forceinline__ void init(int nM_, int nN_, int G_, int c_, int wgm = 4) { nM = nM_; nN = nN_; nwg = nM * nN; G = G_; c = c_; WGM = wgm; }
    __device__ __forceinline__ bool next(int i, Unit& u) const {
        const long L = (long)i * G + c; if (L >= nwg) return false;
        int wgid = (int)L;
#if !defined(ORDER_NOREMAP)
        { const int q = nwg / NXCD, r = nwg % NXCD, xcd = wgid % NXCD, off = wgid / NXCD; wgid = (xcd < r ? xcd * (q + 1) : r * (q + 1) + (xcd - r) * q) + off; }
#endif
        const int nig = WGM * nN, gid = wgid / nig, fm = gid * WGM, gsz = (nM - fm) < WGM ? (nM - fm) : WGM;
#if defined(ORDER_COLFAST)
        u.pm = fm + ((wgid % nig) / nN) % gsz; u.pn = (wgid % nig) % nN; return true;
#else
        u.pm = fm + ((wgid % nig) % gsz); u.pn = (wgid % nig) / gsz; return true;
#endif
    }
};

template <class Epi, class BSel, bool GATHER>
__device__ __forceinline__ void gemm_phase(LAS unsigned char* lds, const bf16_t* A, const int K, const StaticOrder& S, const BSel& bsel, const Epi& E, const LAS unsigned short* rowtab) {
    int tid = threadIdx.x; asm volatile("" : "+v"(tid));
    const int wid = __builtin_amdgcn_readfirstlane(tid >> 6), lane = tid & 63, wr = wid >> 2, wc = wid & 3, fr = lane & 15, fq = lane >> 4;
    const int nt = K / BK;
    unsigned voffA[2], voffB[2]; int RA[2], CA[2];
#pragma unroll
    for (int i = 0; i < 2; ++i) { int R, C; stage_rc(tid * 16 + i * 8192, R, C); const int Rb = Epi::PERM ? ((R & ~31) + perm32(R & 31)) : R;
        voffA[i] = (unsigned)(R * K + C) * 2u; voffB[i] = (unsigned)(Rb * K + C) * 2u; RA[i] = R; CA[i] = C; }
    const size_t kstep = (size_t)(BK * 2);
    const size_t hstep = (size_t)HALF * K * 2;
    const size_t hA = GATHER ? (size_t)0 : hstep;
    const size_t tstep = 2 * hstep;
    const unsigned ldsw = (unsigned)wid * 1024u;
    const int aoff = lds_byte(wr * 64 + fr, fq * 8), boff = lds_byte(wc * 32 + fr, fq * 8);
#define PG8_SA(b, h) (((b) * 2 + (h)) * HTB)
#define PG8_SB(b, h) ((4 + (b) * 2 + (h)) * HTB)
#define PG8_STAGE(bufoff, gbase, voff) do { _Pragma("unroll") for (int _i = 0; _i < 2; ++_i) \
        __builtin_amdgcn_global_load_lds((const unsigned*)((const char*)(gbase) + (voff)[_i]), (LAS unsigned*)(lds + (bufoff) + ldsw + _i * 8192), 16, 0, 0); } while (0)
#define PG8_LDA(dst, b, h) do { _Pragma("unroll") for (int m = 0; m < 4; ++m) ldfrag(dst[m], lds + PG8_SA(b, h) + aoff + m * 2048); } while (0)
#define PG8_LDB(dst, b, h) do { _Pragma("unroll") for (int n = 0; n < 2; ++n) ldfrag(dst[n], lds + PG8_SB(b, h) + boff + n * 2048); } while (0)
#define PG8_MMA(ai, bj, At, Bt) do { __builtin_amdgcn_s_setprio(1); _Pragma("unroll") for (int m = 0; m < 4; ++m) _Pragma("unroll") for (int n = 0; n < 2; ++n) \
        acc[ai][bj][m][n] = mma(Bt[n], At[m], acc[ai][bj][m][n]); __builtin_amdgcn_s_setprio(0); } while (0)
#define PG8_WAIT_V(n) asm volatile("s_waitcnt vmcnt(" #n ")" ::: "memory")
#define PG8_WAIT_L(n) asm volatile("s_waitcnt lgkmcnt(" #n ")" ::: "memory")
#define PG8_BAR __builtin_amdgcn_s_barrier()
#define PG8_SCHED __builtin_amdgcn_sched_barrier(0)
    Unit cur, nxt; int ui = 0;
    if (!S.next(0, cur)) return;
    f32x4 acc[2][2][4][2];
#pragma unroll
    for (int a = 0; a < 2; ++a)
#pragma unroll
        for (int b = 0; b < 2; ++b)
#pragma unroll
            for (int m = 0; m < 4; ++m)
#pragma unroll
                for (int n = 0; n < 2; ++n) acc[a][b][m][n] = (f32x4){0.f, 0.f, 0.f, 0.f};
    Frag<Epi::F8> At[4], B0[2], B1[2];
    unsigned vC0[2], vC1[2], vN0[2], vN1[2];
#pragma unroll
    for (int i = 0; i < 2; ++i) {
        if constexpr (GATHER) { vC0[i] = ((unsigned)rowtab[RA[i]] * (unsigned)K + (unsigned)CA[i]) * 2u; vC1[i] = ((unsigned)rowtab[HALF + RA[i]] * (unsigned)K + (unsigned)CA[i]) * 2u; }
        else { vC0[i] = voffA[i]; vC1[i] = voffA[i]; }
        vN0[i] = vC0[i]; vN1[i] = vC1[i];
    }
    const char* cA = GATHER ? (const char*)A : (const char*)A + (size_t)cur.pm * tstep; const char* cB = bsel(cur);
    PG8_STAGE(PG8_SB(0, 0), cB, voffB); PG8_STAGE(PG8_SB(0, 1), cB + hstep, voffB); PG8_STAGE(PG8_SA(0, 0), cA, vC0); PG8_STAGE(PG8_SA(0, 1), cA + hA, vC1);
    if (wr == 1) PG8_BAR;
    PG8_WAIT_V(2); PG8_BAR;
    PG8_STAGE(PG8_SB(1, 0), cB + kstep, voffB); PG8_STAGE(PG8_SA(1, 0), cA + kstep, vC0); PG8_STAGE(PG8_SB(1, 1), cB + hstep + kstep, voffB);
    PG8_WAIT_V(6); PG8_BAR;
    for (;;) {
        const bool has_next = S.next(ui + 1, nxt);
        const char* nA = GATHER ? (const char*)A : (has_next ? (const char*)A + (size_t)nxt.pm * tstep : cA); const char* nB = has_next ? bsel(nxt) : cB;
        for (int t = 0; t < nt; t += 2) {
            const bool last = (t == nt - 2);
            const char* a1 = cA + (size_t)(t + 1) * kstep;
            const char* a2 = last ? nA : cA + (size_t)(t + 2) * kstep; const char* b2 = last ? nB : cB + (size_t)(t + 2) * kstep;
            const char* a3 = a2 + kstep; const char* b3 = b2 + kstep;
            unsigned s0[2], s1[2];
            if constexpr (GATHER) {
                if (last && has_next) {
#pragma unroll
                    for (int i = 0; i < 2; ++i) { vN0[i] = ((unsigned)rowtab[(ui + 1) * 256 + RA[i]] * (unsigned)K + (unsigned)CA[i]) * 2u; vN1[i] = ((unsigned)rowtab[(ui + 1) * 256 + HALF + RA[i]] * (unsigned)K + (unsigned)CA[i]) * 2u; }
                }
#pragma unroll
                for (int i = 0; i < 2; ++i) { s0[i] = last ? vN0[i] : vC0[i]; s1[i] = last ? vN1[i] : vC1[i]; }
            } else {
#pragma unroll
                for (int i = 0; i < 2; ++i) { s0[i] = voffA[i]; s1[i] = voffA[i]; }
            }
            PG8_LDB(B0, 0, 0); PG8_LDB(B1, 0, 1); PG8_SCHED; PG8_LDA(At, 0, 0); PG8_STAGE(PG8_SA(1, 1), a1 + hA, vC1);
            PG8_WAIT_V(8); PG8_WAIT_L(0); PG8_BAR; PG8_MMA(0, 0, At, B0); PG8_MMA(0, 1, At, B1); PG8_BAR; PG8_SCHED;
            PG8_LDA(At, 0, 1); PG8_STAGE(PG8_SB(0, 0), b2, voffB); PG8_STAGE(PG8_SB(0, 1), b2 + hstep, voffB); PG8_STAGE(PG8_SA(0, 0), a2, s0);
            PG8_WAIT_V(8); PG8_WAIT_L(0); PG8_BAR; PG8_MMA(1, 0, At, B0); PG8_MMA(1, 1, At, B1); PG8_BAR; PG8_SCHED;
            PG8_LDB(B0, 1, 0); PG8_LDB(B1, 1, 1); PG8_SCHED; PG8_LDA(At, 1, 0); PG8_STAGE(PG8_SA(0, 1), a2 + hA, s1);
            PG8_WAIT_V(8); PG8_WAIT_L(0); PG8_BAR; PG8_MMA(0, 0, At, B0); PG8_MMA(0, 1, At, B1); PG8_BAR; PG8_SCHED;
            PG8_LDA(At, 1, 1); PG8_STAGE(PG8_SB(1, 0), b3, voffB); PG8_STAGE(PG8_SB(1, 1), b3 + hstep, voffB); PG8_STAGE(PG8_SA(1, 0), a3, s0);
            PG8_WAIT_V(8); PG8_WAIT_L(0); PG8_BAR; PG8_MMA(1, 0, At, B0); PG8_MMA(1, 1, At, B1); PG8_BAR; PG8_SCHED;
        }
        if constexpr (Epi::F8) asm volatile("s_nop 15\n\ts_nop 15\n\ts_nop 15" ::: "memory");
        if (wr == 0) PG8_BAR;
        E(acc, cur, wr, wc, fr, fq);
        if (!has_next) break;
#pragma unroll
        for (int a = 0; a < 2; ++a)
#pragma unroll
            for (int b = 0; b < 2; ++b)
#pragma unroll
                for (int m = 0; m < 4; ++m)
#pragma unroll
                    for (int n = 0; n < 2; ++n) acc[a][b][m][n] = (f32x4){0.f, 0.f, 0.f, 0.f};
        cur = nxt; cA = nA; cB = nB; ++ui;
#pragma unroll
        for (int i = 0; i < 2; ++i) { vC0[i] = vN0[i]; vC1[i] = vN1[i]; }
        if (wr == 1) PG8_BAR;
    }
    PG8_WAIT_V(0);
    PG8_BAR;
#undef PG8_SA
#undef PG8_SB
#undef PG8_STAGE
#undef PG8_LDA
#undef PG8_LDB
#undef PG8_MMA
#undef PG8_WAIT_V
#undef PG8_WAIT_L
#undef PG8_BAR
#undef PG8_SCHED
}
}
struct BPlain { const char* Bt; size_t tstep; __device__ __forceinline__ const char* operator()(const pg8::Unit& u) const { return Bt + (size_t)u.pn * tstep; } };
template <bool F8_> struct BWin {
    const char* Bt; size_t tstep;
    static __device__ __forceinline__ int tile(int p) { return F8_ ? (p < WIN8_LO ? p : p + (WIN8_HI - WIN8_LO)) : p + WIN8_LO; }
    __device__ __forceinline__ const char* operator()(const pg8::Unit& u) const { return Bt + (size_t)tile(u.pn) * tstep; } };
struct BExpert { const char* Bt; size_t estride, tstep; const int* blke; __device__ __forceinline__ const char* operator()(const pg8::Unit& u) const { return Bt + (size_t)blke[u.pm] * estride + (size_t)u.pn * tstep; } };

__device__ __forceinline__ u32x4 pack8bf(const f32x4 v0, const f32x4 v1) { u32x4 w; w.x = cvt_pk_bf16(v0[0], v0[1]); w.y = cvt_pk_bf16(v0[2], v0[3]); w.z = cvt_pk_bf16(v1[0], v1[1]); w.w = cvt_pk_bf16(v1[2], v1[3]); return w; }
__device__ __forceinline__ void unpack8bf(const u32x4 w, f32x4& v0, f32x4& v1) { v0 = (f32x4){bf_lo(w.x), bf_hi(w.x), bf_lo(w.y), bf_hi(w.y)}; v1 = (f32x4){bf_lo(w.z), bf_hi(w.z), bf_lo(w.w), bf_hi(w.w)}; }
__device__ __forceinline__ f32x4 sig4(const f32x4 v) { return (f32x4){fast_sigmoid(v[0]), fast_sigmoid(v[1]), fast_sigmoid(v[2]), fast_sigmoid(v[3])}; }

template <bool F8_> struct EpiIn {
    static constexpr bool PERM = true, F8 = F8_;
    static constexpr float SC = F8_ ? 1.0f / (ACT8_H1 * W8_SCALE) : 1.0f;
    bf16_t *Q, *Kt, *V, *QI, *KI, *GB, *CU, *SGA, *SGB; float* WI;
    __device__ __forceinline__ void operator()(const f32x4 (&acc)[2][2][4][2], const pg8::Unit& u, int wr, int wc, int fr, int fq) const {
        const int row0 = u.pm * 256 + wr * 64 + fr, pn = BWin<F8_>::tile(u.pn), c8 = wc * 32 + 8 * fq;
        if (pn == 16) {
#pragma unroll
            for (int ai = 0; ai < 2; ++ai)
#pragma unroll
                for (int m = 0; m < 4; ++m) { const size_t row = (size_t)(row0 + ai * 128 + m * 16);
                    if (wc < 2) { const f32x4 k0 = acc[ai][0][m][0] * (SC * QKV8_SCALE), k1 = acc[ai][0][m][1] * (SC * QKV8_SCALE);
                        *(u32x2*)((unsigned char*)KI + row * 64 + c8) = (u32x2){pk4_fp8(sat8(k0[0]), sat8(k0[1]), sat8(k0[2]), sat8(k0[3])), pk4_fp8(sat8(k1[0]), sat8(k1[1]), sat8(k1[2]), sat8(k1[3]))}; }
                    else if (wc == 2 && fq < 2) { *(f32x4*)(WI + row * 16 + 8 * fq) = acc[ai][0][m][0] * SC; *(f32x4*)(WI + row * 16 + 8 * fq + 4) = acc[ai][0][m][1] * SC; } }
            return;
        }
        if (pn >= 21 && pn < 29) {
#pragma unroll
            for (int ai = 0; ai < 2; ++ai)
#pragma unroll
                for (int m = 0; m < 4; ++m) { const size_t row = (size_t)(row0 + ai * 128 + m * 16);
                    *(u32x4*)(CU + row * 1024 + (pn - 21) * 128 + c8) = pack8bf(acc[ai][0][m][0] * acc[ai][1][m][0] * (SC * SC), acc[ai][0][m][1] * acc[ai][1][m][1] * (SC * SC)); }
            return;
        }
        if (F8_ && pn < 12) {
            const int t = pn >> 2;
#pragma unroll
            for (int ai = 0; ai < 2; ++ai)
#pragma unroll
                for (int m = 0; m < 4; ++m) { const int row = row0 + ai * 128 + m * 16;
#pragma unroll
                    for (int bj = 0; bj < 2; ++bj) { const int head = 2 * (pn & 3) + bj; const f32x4 v0 = acc[ai][bj][m][0] * (SC * QKV8_SCALE), v1 = acc[ai][bj][m][1] * (SC * QKV8_SCALE);
                        const unsigned w0 = pk4_fp8(sat8(v0[0]), sat8(v0[1]), sat8(v0[2]), sat8(v0[3])), w1 = pk4_fp8(sat8(v1[0]), sat8(v1[1]), sat8(v1[2]), sat8(v1[3]));
                        if (t < 2) *(u32x2*)((unsigned char*)Q + (size_t)t * (WS_K - WS_Q) + ((size_t)head * M + row) * 128 + c8) = (u32x2){w0, w1};
                        else { unsigned char* vb = (unsigned char*)V + ((size_t)head * M + (size_t)(row & ~63)) * 128 + (size_t)c8 * 64 + vt_pos(row & 63);
#pragma unroll
                            for (int e_ = 0; e_ < 4; ++e_) { vb[e_ * 64] = (unsigned char)(w0 >> (8 * e_)); vb[(4 + e_) * 64] = (unsigned char)(w1 >> (8 * e_)); } } } }
            return;
        }
        if (pn >= 12 && pn < 16) {
#pragma unroll
            for (int ai = 0; ai < 2; ++ai)
#pragma unroll
                for (int m = 0; m < 4; ++m) { const size_t row = (size_t)(row0 + ai * 128 + m * 16);
#pragma unroll
                    for (int bj = 0; bj < 2; ++bj) { const f32x4 v0 = acc[ai][bj][m][0] * (SC * QKV8_SCALE), v1 = acc[ai][bj][m][1] * (SC * QKV8_SCALE);
                        *(u32x2*)((unsigned char*)QI + row * 1024 + (pn - 12) * 256 + bj * 128 + c8) = (u32x2){pk4_fp8(sat8(v0[0]), sat8(v0[1]), sat8(v0[2]), sat8(v0[3])), pk4_fp8(sat8(v1[0]), sat8(v1[1]), sat8(v1[2]), sat8(v1[3]))}; } }
            return;
        }
        bf16_t* dst; int ld; size_t bjs; bool sig = false;
        if (pn < 12) { const int t = pn >> 2; dst = Q + (size_t)t * ((WS_K - WS_Q) / 2) + (size_t)(2 * (pn & 3)) * M * 128; ld = 128; bjs = (size_t)M * 128; }
        else if (pn < 16) { dst = QI + (pn - 12) * 256; ld = 1024; bjs = 128; }
        else if (pn < 21) { dst = GB + (pn - 17) * 256; ld = 1024; bjs = 128; }
        else if (pn < 37) { dst = SGA + (pn - 29) * 256; ld = 2048; bjs = 128; sig = true; }
        else { dst = SGB + (pn - 37) * 256; ld = 2048; bjs = 128; sig = true; }
#pragma unroll
        for (int ai = 0; ai < 2; ++ai)
#pragma unroll
            for (int m = 0; m < 4; ++m) { bf16_t* rp = dst + (size_t)(row0 + ai * 128 + m * 16) * ld + c8;
#pragma unroll
                for (int bj = 0; bj < 2; ++bj) { f32x4 v0 = acc[ai][bj][m][0] * SC, v1 = acc[ai][bj][m][1] * SC;
                    if (sig) { v0 = sig4(v0); v1 = sig4(v1); }
                    *(u32x4*)(rp + bj * bjs) = pack8bf(v0, v1); } }
    }
};
template <bool HAS_ADD, int ASCALE = 0> struct EpiGate {
    static constexpr bool PERM = true, F8 = ASCALE > 0;
    static constexpr float SC = ASCALE > 0 ? 1.0f / ((float)ASCALE * W8_SCALE) : 1.0f;
    const bf16_t* G; const bf16_t* ADD; bf16_t* O;
    __device__ __forceinline__ void operator()(const f32x4 (&acc)[2][2][4][2], const pg8::Unit& u, int wr, int wc, int fr, int fq) const {
        const int row0 = u.pm * 256 + wr * 64 + fr, col0 = u.pn * 256 + wc * 32 + 8 * fq;
#pragma unroll
        for (int ai = 0; ai < 2; ++ai)
#pragma unroll
            for (int m = 0; m < 4; ++m) { const size_t off = (size_t)(row0 + ai * 128 + m * 16) * 2048 + col0;
#pragma unroll
                for (int bj = 0; bj < 2; ++bj) { f32x4 g0, g1; unpack8bf(*(const u32x4*)(G + off + bj * 128), g0, g1);
                    f32x4 v0 = acc[ai][bj][m][0] * g0 * SC, v1 = acc[ai][bj][m][1] * g1 * SC;
                    if (HAS_ADD) { f32x4 a0, a1; unpack8bf(*(const u32x4*)(ADD + off + bj * 128), a0, a1); v0 += a0; v1 += a1; }
                    *(u32x4*)(O + off + bj * 128) = pack8bf(v0, v1); } }
    }
};
struct EpiY1 {
    static constexpr bool PERM = false, F8 = false;
    const float* x; const float* mu; const float* rstd; const float* g; const float* b; float* Y;
    __device__ __forceinline__ void operator()(const f32x4 (&acc)[2][2][4][2], const pg8::Unit& u, int wr, int wc, int fr, int fq) const {
        const int row0 = u.pm * 256 + wr * 64 + fr, col0 = u.pn * 256 + wc * 32 + 4 * fq;
        f32x4 gv[2][2], bv[2][2];
#pragma unroll
        for (int bj = 0; bj < 2; ++bj)
#pragma unroll
            for (int n = 0; n < 2; ++n) { gv[bj][n] = *(const f32x4*)(g + col0 + bj * 128 + n * 16) * DN_ALPHA; bv[bj][n] = *(const f32x4*)(b + col0 + bj * 128 + n * 16) * DN_ALPHA; }
#pragma unroll
        for (int ai = 0; ai < 2; ++ai)
#pragma unroll
            for (int m = 0; m < 4; ++m) { const int row = row0 + ai * 128 + m * 16; const float mr = mu[row], rs = rstd[row]; const size_t off = (size_t)row * 2048 + col0;
#pragma unroll
                for (int bj = 0; bj < 2; ++bj)
#pragma unroll
                    for (int n = 0; n < 2; ++n) { const f32x4 xv = *(const f32x4*)(x + off + bj * 128 + n * 16);
                        *(f32x4*)(Y + off + bj * 128 + n * 16) = ((xv - mr) * rs) * gv[bj][n] + bv[bj][n] + acc[ai][bj][m][n]; } }
    }
};
struct EpiPlain {
    static constexpr bool PERM = true, F8 = false;
    bf16_t* O;
    __device__ __forceinline__ void operator()(const f32x4 (&acc)[2][2][4][2], const pg8::Unit& u, int wr, int wc, int fr, int fq) const {
        const int row0 = u.pm * 256 + wr * 64 + fr, col0 = u.pn * 256 + wc * 32 + 8 * fq;
#pragma unroll
        for (int ai = 0; ai < 2; ++ai)
#pragma unroll
            for (int m = 0; m < 4; ++m) { const size_t off = (size_t)(row0 + ai * 128 + m * 16) * 2048 + col0;
#pragma unroll
                for (int bj = 0; bj < 2; ++bj) *(u32x4*)(O + off + bj * 128) = pack8bf(acc[ai][bj][m][0], acc[ai][bj][m][1]); }
    }
};
struct EpiPle {
    static constexpr bool PERM = true, F8 = true;
    bf16_t* PP;
    __device__ __forceinline__ void operator()(const f32x4 (&acc)[2][2][4][2], const pg8::Unit& u, int wr, int wc, int fr, int fq) const {
        const int row0 = u.pm * 256 + wr * 64 + fr, col0 = u.pn * 256 + wc * 32 + 8 * fq;
#pragma unroll
        for (int ai = 0; ai < 2; ++ai)
#pragma unroll
            for (int m = 0; m < 4; ++m) { const size_t off = (size_t)(row0 + ai * 128 + m * 16) * 2048 + col0;
#pragma unroll
                for (int bj = 0; bj < 2; ++bj) { f32x4 p0, p1; unpack8bf(*(const u32x4*)(PP + off + bj * 128), p0, p1);
                    *(u32x4*)(PP + off + bj * 128) = pack8bf(sig4(acc[ai][bj][m][0] * (1.0f / (ACT8_H1 * W8_SCALE))) * p0, sig4(acc[ai][bj][m][1] * (1.0f / (ACT8_H1 * W8_SCALE))) * p1); } }
    }
};
struct EpiAct {
    static constexpr bool PERM = true, F8 = true;
    const float* bg; const float* bu; const int* blke; unsigned char* ACT;
    __device__ __forceinline__ void operator()(const f32x4 (&acc)[2][2][4][2], const pg8::Unit& u, int wr, int wc, int fr, int fq) const {
        const int row0 = u.pm * 256 + wr * 64 + fr, col0 = u.pn * 128 + wc * 32 + 8 * fq, e = blke[u.pm];
        const f32x4 bg0 = *(const f32x4*)(bg + e * 2048 + col0), bg1 = *(const f32x4*)(bg + e * 2048 + col0 + 4), bu0 = *(const f32x4*)(bu + e * 2048 + col0), bu1 = *(const f32x4*)(bu + e * 2048 + col0 + 4);
#pragma unroll
        for (int ai = 0; ai < 2; ++ai)
#pragma unroll
            for (int m = 0; m < 4; ++m) { const size_t off = (size_t)(row0 + ai * 128 + m * 16) * 2048 + col0;
                f32x2 o[2][2];
#pragma unroll
                for (int n = 0; n < 2; ++n)
#pragma unroll
                    for (int h = 0; h < 2; ++h) { constexpr float SCg = 1.0f / (ACT8_H1 * W8_SCALE), KE = -1.702f * 1.4426950408889634f;
                        const f32x4 ag4 = acc[ai][0][m][n], au4 = acc[ai][1][m][n], bgv = n ? bg1 : bg0, buv = n ? bu1 : bu0;
                        const f32x2 gg = __builtin_elementwise_fma((f32x2){ag4[2 * h], ag4[2 * h + 1]}, (f32x2){SCg, SCg}, (f32x2){bgv[2 * h], bgv[2 * h + 1]});
                        const f32x2 uu = __builtin_elementwise_fma((f32x2){au4[2 * h], au4[2 * h + 1]}, (f32x2){SCg, SCg}, (f32x2){buv[2 * h], buv[2 * h + 1]});
                        const f32x2 gc = {fminf(gg[0], 7.0f), fminf(gg[1], 7.0f)}, uc = {__builtin_amdgcn_fmed3f(uu[0], -7.0f, 7.0f), __builtin_amdgcn_fmed3f(uu[1], -7.0f, 7.0f)};
                        const f32x2 x = gc * (f32x2){KE, KE};
                        const f32x2 d = (f32x2){__builtin_amdgcn_exp2f(x[0]), __builtin_amdgcn_exp2f(x[1])} + (f32x2){1.0f, 1.0f};
                        const f32x2 sg = {__builtin_amdgcn_rcpf(d[0]), __builtin_amdgcn_rcpf(d[1])};
                        o[n][h] = __builtin_elementwise_fma(uc, (f32x2){ACT8_A, ACT8_A}, (f32x2){ACT8_A, ACT8_A}) * (gc * sg); }
                *(u32x2*)(ACT + off) = (u32x2){pk4_fp8(o[0][0][0], o[0][0][1], o[0][1][0], o[0][1][1]), pk4_fp8(o[1][0][0], o[1][0][1], o[1][1][0], o[1][1][1])}; }
    }
};
struct EpiDown {
    static constexpr bool PERM = true, F8 = true;
    const float* bd; const int* blke; const float* roww; unsigned char* OW;
    __device__ __forceinline__ void operator()(const f32x4 (&acc)[2][2][4][2], const pg8::Unit& u, int wr, int wc, int fr, int fq) const {
        const int row0 = u.pm * 256 + wr * 64 + fr, col0 = u.pn * 256 + wc * 32 + 8 * fq, e = blke[u.pm];
        f32x4 bv[2][2];
#pragma unroll
        for (int bj = 0; bj < 2; ++bj)
#pragma unroll
            for (int n = 0; n < 2; ++n) bv[bj][n] = *(const f32x4*)(bd + e * 2048 + col0 + bj * 128 + 4 * n);
#pragma unroll
        for (int ai = 0; ai < 2; ++ai)
#pragma unroll
            for (int m = 0; m < 4; ++m) { const int row = row0 + ai * 128 + m * 16; const float w = roww[row]; const size_t off = (size_t)row * 2048 + col0;
#pragma unroll
                for (int bj = 0; bj < 2; ++bj) { const f32x4 x0 = (acc[ai][bj][m][0] * (1.0f / (ACT8_A * W8_SCALE)) + bv[bj][0]) * (w * OW8_SCALE), x1 = (acc[ai][bj][m][1] * (1.0f / (ACT8_A * W8_SCALE)) + bv[bj][1]) * (w * OW8_SCALE);
                    *(u32x2*)(OW + off + bj * 128) = (u32x2){pk4_fp8(sat8(x0[0]), sat8(x0[1]), sat8(x0[2]), sat8(x0[3])), pk4_fp8(sat8(x1[0]), sat8(x1[1]), sat8(x1[2]), sat8(x1[3]))}; } }
    }
};
struct Args { const float* in[24]; float* out; unsigned char* ws; };
struct Frame {
    LAS unsigned char* lds;
    int tid, lane, wave, wg, G;
    const Args* a;
    float* out; unsigned char* ws;
    __device__ __forceinline__ const float* inp(int i) const { asm volatile("" : "+s"(i)); return a->in[i]; }
};
enum { I_X = 0, I_P, I_LNG, I_LNB, I_RELB, I_WIN, I_CONVW, I_WATT, I_WCONV, I_WO, I_LN1G, I_LN1B, I_WR, I_BR, I_WG, I_BG, I_WU, I_BU, I_WD, I_BD, I_WPG, I_WPP, I_LN2G, I_LN2B };

__device__ __forceinline__ int win_dst_row(int n) {
    if (n < 4176) return n;
    if (n < 5200) return 4352 + (n - 4176);
    if (n < 6224) { const int c = n - 5200; return 5376 + (c >> 7) * 256 + (c & 127); }
    if (n < 7248) { const int c = n - 6224; return 5376 + (c >> 7) * 256 + 128 + (c & 127); }
    return 7424 + (n - 7248);
}
struct TrItem { const float* W; bf16_t* WT; int K, N, k0, n0, map; };
constexpr int TR_LDS_STRIDE = 64 * 65 * 4;
__device__ __forceinline__ void tr_load(const TrItem& t, float (&r)[64], int lane) {
    const int nl = t.n0 + lane;
#pragma unroll
    for (int i = 0; i < 64; ++i) r[i] = (nl < t.N) ? __builtin_nontemporal_load(t.W + (size_t)(t.k0 + i) * t.N + nl) : 0.f;
}
template <int F8> __device__ __forceinline__ void tr_store(const TrItem& t, const float (&r)[64], LAS float* scr, int lane, unsigned char* ws) {
#pragma unroll
    for (int i = 0; i < 64; ++i) scr[i * 65 + lane] = r[i];
    LDS_WAIT(); asm volatile("" ::: "memory");
    const int c = lane & 7;
#pragma unroll
    for (int j = 0; j < 8; ++j) { const int nn = (lane >> 3) + 8 * j, n = t.n0 + nn; const LAS float* s = scr + (8 * c) * 65 + nn;
        u32x4 o; o.x = pk2(s[0 * 65], s[1 * 65]); o.y = pk2(s[2 * 65], s[3 * 65]); o.z = pk2(s[4 * 65], s[5 * 65]); o.w = pk2(s[6 * 65], s[7 * 65]);
        int dr = n;
        if (t.map == 1) dr = win_dst_row(n);
        if (t.map == 2) dr = (n >> 7) * 256 + (n & 127);
        if (t.map == 3) dr = (n >> 7) * 256 + 128 + (n & 127);
        if constexpr (F8 != 0) {
            const u32x2 o8 = {pk4_fp8(sat8(s[0 * 65] * W8_SCALE), sat8(s[1 * 65] * W8_SCALE), sat8(s[2 * 65] * W8_SCALE), sat8(s[3 * 65] * W8_SCALE)), pk4_fp8(sat8(s[4 * 65] * W8_SCALE), sat8(s[5 * 65] * W8_SCALE), sat8(s[6 * 65] * W8_SCALE), sat8(s[7 * 65] * W8_SCALE))};
            if constexpr (F8 == 1) { if (n < t.N) __builtin_nontemporal_store(o8, (u32x2*)((unsigned char*)t.WT + (size_t)dr * t.K + t.k0 + 8 * c)); }
            else { const bool f8row = win_tile_f8(dr >> 8);
                if (n < t.N && f8row) __builtin_nontemporal_store(o8, (u32x2*)(ws + WS_WIN8 + (size_t)dr * t.K + t.k0 + 8 * c));
                if (n < t.N && !f8row) __builtin_nontemporal_store(o, (u32x4*)(t.WT + (size_t)dr * t.K + t.k0 + 8 * c)); }
        } else if (n < t.N) __builtin_nontemporal_store(o, (u32x4*)(t.WT + (size_t)dr * t.K + t.k0 + 8 * c)); }
    LDS_WAIT(); asm volatile("" ::: "memory");
}
__device__ __forceinline__ TrItem tr_make(const float* W, int K, int N, bf16_t* WT, int item, int map) {
    const int nblk = (N + 63) / 64, kb = item / nblk, nb = item % nblk; TrItem t; t.W = W; t.WT = WT; t.K = K; t.N = N; t.k0 = 64 * kb; t.n0 = 64 * nb; t.map = map; return t;
}
__device__ __forceinline__ TrItem win_item(const Frame& F, int it) { return tr_make(F.inp(I_WIN), 2048, IN_COLS, (bf16_t*)(F.ws + WS_WIN), it, 1); }
__device__ __forceinline__ TrItem p0_item(const Frame& F, int it) {
    constexpr int I_O = 32 * 32;
    int r = it;
    if (r < I_O) return tr_make(F.inp(I_WO), 2048, 2048, (bf16_t*)(F.ws + WS_WO), r, 0); r -= I_O;
    return tr_make(F.inp(I_WPP), 256, 2048, (bf16_t*)(F.ws + WS_WPP), r, 0);
}
__device__ __forceinline__ TrItem moe_item_w1(const Frame& F, int it) {
    constexpr int PER = 32 * 32;
    const int e = it / (2 * PER), r = it % (2 * PER), which = r / PER, item = r % PER; const size_t wo = (size_t)e * 2048 * 2048;
    if (which == 0) return tr_make(F.inp(I_WG) + wo, 2048, 2048, (bf16_t*)(F.ws + WS_W1 + (size_t)e * 4096 * 2048), item, 2);
    return tr_make(F.inp(I_WU) + wo, 2048, 2048, (bf16_t*)(F.ws + WS_W1 + (size_t)e * 4096 * 2048), item, 3);
}
__device__ __forceinline__ TrItem moe_item_w2(const Frame& F, int it) {
    constexpr int PER = 32 * 32;
    const int e = it / PER, item = it % PER; const size_t wo = (size_t)e * 2048 * 2048;
    return tr_make(F.inp(I_WD) + wo, 2048, 2048, (bf16_t*)(F.ws + WS_W2 + wo), item, 0);
}
__device__ __forceinline__ TrItem wa_item(const Frame& F, int it) { return tr_make(F.inp(I_WATT), 1024, 2048, (bf16_t*)(F.ws + WS_WA), it, 0); }
__device__ __forceinline__ TrItem wb_item(const Frame& F, int it) { return tr_make(F.inp(I_WCONV), 1024, 2048, (bf16_t*)(F.ws + WS_WB), it, 0); }
__device__ __forceinline__ TrItem wpg_item(const Frame& F, int it) { return tr_make(F.inp(I_WPG), 2048, 2048, (bf16_t*)(F.ws + WS_WPG), it, 0); }
#define TR_LOOP(MAKE, NITEMS, F8) do { const int gw_ = F.wg * NWAVES + F.wave, NGW_ = F.G * NWAVES; LAS float* scr_ = (LAS float*)(F.lds + F.wave * TR_LDS_STRIDE); \
    int it_ = gw_; if (it_ < (NITEMS)) { TrItem cur_ = MAKE(F, it_); float ra_[64]; tr_load(cur_, ra_, F.lane); \
        for (;;) { const int nx_ = it_ + NGW_; const bool more_ = nx_ < (NITEMS); TrItem nxt_ = cur_; float rb_[64]; if (more_) { nxt_ = MAKE(F, nx_); tr_load(nxt_, rb_, F.lane); } \
            tr_store<F8>(cur_, ra_, scr_, F.lane, F.ws); if (!more_) break; \
            _Pragma("unroll") for (int q_ = 0; q_ < 64; ++q_) ra_[q_] = rb_[q_]; cur_ = nxt_; it_ = nx_; } } } while (0)
__device__ __forceinline__ void p0_prologue(const Frame& F) {
    const int gw = F.wg * NWAVES + F.wave, NGW = F.G * NWAVES;
    bf16_t* WinT = (bf16_t*)(F.ws + WS_WIN);
    constexpr int NITEMS = 32 * 32 + 4 * 32;
    TR_LOOP(win_item, 32 * 178, 2);
    TR_LOOP(p0_item, NITEMS, 0);
    TR_LOOP(wpg_item, 32 * 32, 1);
    TR_LOOP(wb_item, 16 * 32, 1);
    TR_LOOP(wa_item, 16 * 32, 1);
    { const float* wr = F.inp(I_WR); bf16_t* WRH = (bf16_t*)(F.ws + WS_WRH); bf16_t* WRL = (bf16_t*)(F.ws + WS_WRL);
      for (int i = gw * 64 + F.lane; i < 2048 * 32; i += NGW * 64) { const int c = i >> 5, e = i & 31; const float w = wr[i]; const unsigned h = f2bf(w); WRH[(size_t)e * 2048 + c] = (bf16_t)h; WRL[(size_t)e * 2048 + c] = (bf16_t)f2bf(w - bf_lo(h)); } }
    for (int i = gw * 64 + F.lane; i < 176 * 2048 / 8; i += NGW * 64) *(u32x4*)(WinT + (size_t)4176 * 2048 + (size_t)i * 8) = (u32x4){0u, 0u, 0u, 0u};
    { const float* p = F.inp(I_P); bf16_t* PB = (bf16_t*)(F.ws + WS_PB);
      for (int i = gw * 64 + F.lane; i < M * 256 / 8; i += NGW * 64) { const f32x4 a = *(const f32x4*)(p + (size_t)i * 8), b = *(const f32x4*)(p + (size_t)i * 8 + 4);
          *(u32x4*)(PB + (size_t)i * 8) = (u32x4){pk2(a[0], a[1]), pk2(a[2], a[3]), pk2(b[0], b[1]), pk2(b[2], b[3])}; } }
    { const float* x = F.inp(I_X); const float* g = F.inp(I_LNG); const float* bb = F.inp(I_LNB); bf16_t* HB = (bf16_t*)(F.ws + WS_HB);
      float* mu = (float*)(F.ws + WS_STATS); float* rstd = mu + M;
      f32x4 gv[8], bv[8];
#pragma unroll
      for (int j = 0; j < 8; ++j) { gv[j] = *(const f32x4*)(g + 4 * F.lane + 256 * j); bv[j] = *(const f32x4*)(bb + 4 * F.lane + 256 * j); }
      for (int m = gw; m < M; m += NGW) {
          const float* xr = x + (size_t)m * D + 4 * F.lane; f32x4 v[8]; float s = 0.f;
#pragma unroll
          for (int j = 0; j < 8; ++j) { v[j] = __builtin_nontemporal_load((const f32x4*)(xr + 256 * j)); s += (v[j][0] + v[j][1]) + (v[j][2] + v[j][3]); }
          const float mean = wave_sum(s) * (1.f / D); float s2 = 0.f;
#pragma unroll
          for (int j = 0; j < 8; ++j) { v[j] = v[j] - mean; s2 += (v[j][0] * v[j][0] + v[j][1] * v[j][1]) + (v[j][2] * v[j][2] + v[j][3] * v[j][3]); }
          const float rs = 1.f / sqrtf(wave_sum(s2) * (1.f / D) + LN_EPS);
          if (F.lane == 0) { mu[m] = mean; rstd[m] = rs; }
          bf16_t* orow = HB + (size_t)m * D + 4 * F.lane; unsigned char* orow8 = F.ws + WS_HB8 + (size_t)m * D + 4 * F.lane;
#pragma unroll
          for (int j = 0; j < 8; ++j) { const f32x4 y = v[j] * rs * gv[j] + bv[j]; *(u32x2*)(orow + 256 * j) = (u32x2){pk2(y[0], y[1]), pk2(y[2], y[3])};
              *(unsigned*)(orow8 + 256 * j) = pk4_fp8(sat8(y[0] * ACT8_H1), sat8(y[1] * ACT8_H1), sat8(y[2] * ACT8_H1), sat8(y[3] * ACT8_H1)); }
      } }
}
__device__ __forceinline__ void moe_w1_convert(const Frame& F) { TR_LOOP(moe_item_w1, NEXP * 2 * 32 * 32, 1); }
__device__ __forceinline__ void moe_w2_convert(const Frame& F) { TR_LOOP(moe_item_w2, NEXP * 32 * 32, 1); }
__device__ __forceinline__ void conv_phase(const Frame& F) {
    bf16_t* GB = (bf16_t*)(F.ws + WS_GB); const bf16_t* CU = (const bf16_t*)(F.ws + WS_CU); const float* cw = F.inp(I_CONVW);
    const int c8 = (F.tid & 127) * 8;
    f32x4 w0a = *(const f32x4*)(cw + c8), w0b = *(const f32x4*)(cw + c8 + 4), w1a = *(const f32x4*)(cw + 1024 + c8), w1b = *(const f32x4*)(cw + 1024 + c8 + 4), w2a = *(const f32x4*)(cw + 2048 + c8), w2b = *(const f32x4*)(cw + 2048 + c8 + 4);
    for (int m = F.wg * 4 + (F.tid >> 7); m < M; m += F.G * 4) {
        const int s = m & (SEQ - 1); const size_t off = (size_t)m * 1024 + c8;
        f32x4 a0, a1, b0, b1, c0, c1, g0, g1;
        unpack8bf(*(const u32x4*)(CU + off), c0, c1);
        if (s >= 1) unpack8bf(*(const u32x4*)(CU + off - 1024), b0, b1); else { b0 = (f32x4){0.f, 0.f, 0.f, 0.f}; b1 = b0; }
        if (s >= 2) unpack8bf(*(const u32x4*)(CU + off - 2048), a0, a1); else { a0 = (f32x4){0.f, 0.f, 0.f, 0.f}; a1 = a0; }
        unpack8bf(*(const u32x4*)(GB + off), g0, g1);
        { const f32x4 r0 = g0 * (w0a * a0 + w1a * b0 + w2a * c0) * GB8_SCALE, r1 = g1 * (w0b * a1 + w1b * b1 + w2b * c1) * GB8_SCALE;
          *(u32x2*)(F.ws + WS_GB8 + off) = (u32x2){pk4_fp8(sat8(r0[0]), sat8(r0[1]), sat8(r0[2]), sat8(r0[3])), pk4_fp8(sat8(r1[0]), sat8(r1[1]), sat8(r1[2]), sat8(r1[3]))}; }
    }
}
__device__ __forceinline__ size_t sc_row_off(int b, int s) { const int c = s >> 6; return (size_t)b * SC_BATCH + (size_t)2048 * c * (c + 1) + (size_t)(s & 63) * 64 * (c + 1); }
__device__ __forceinline__ unsigned sortable_pk(float a, float b) {
    typedef __fp16 h2 __attribute__((ext_vector_type(2)));
    const h2 h = __builtin_amdgcn_cvt_pkrtz(a, b); const unsigned u = __builtin_bit_cast(unsigned, h);
    const s16x2 sv = __builtin_bit_cast(s16x2, u); const s16x2 sg = sv >> 15; const unsigned m = __builtin_bit_cast(unsigned, sg);
    return u ^ (m | 0x80008000u);
}
__device__ __forceinline__ void indexer_chunk(const Frame& F, int b, int c) {
    if (c < 4) return;
    const unsigned char* QI = F.ws + WS_QI; const unsigned char* KI = F.ws + WS_KI; const float* WI = (const float*)(F.ws + WS_WI);
    unsigned short* SC = (unsigned short*)(F.ws + WS_SC);
    const int L = 64 * (c + 1), qg = F.wave & 1, kh = F.wave >> 1, n = F.lane & 31, g = F.lane >> 5;
    const int sq = 64 * c + 32 * qg + n; const size_t mq = (size_t)b * SEQ + sq;
    i32x8 qf[16];
#pragma unroll
    for (int h = 0; h < 16; ++h) { const unsigned char* qp = QI + mq * 1024 + h * 64 + 32 * g; qf[h] = __builtin_shufflevector(*(const i32x4*)qp, *(const i32x4*)(qp + 16), 0, 1, 2, 3, 4, 5, 6, 7); }
    float w[16];
#pragma unroll
    for (int j = 0; j < 4; ++j) { const f32x4 t4 = *(const f32x4*)(WI + mq * 16 + 4 * j) * (1.0f / (QKV8_SCALE * QKV8_SCALE)); w[4 * j] = t4[0]; w[4 * j + 1] = t4[1]; w[4 * j + 2] = t4[2]; w[4 * j + 3] = t4[3]; }
    unsigned short* srow = SC + sc_row_off(b, sq) + 4 * g;
    const unsigned char* kp = KI + ((size_t)b * SEQ + n) * 64 + 32 * g;
    const int nt = L / 32;
    if (kh >= nt) return;
    i32x8 a = __builtin_shufflevector(*(const i32x4*)(kp + (size_t)(32 * kh) * 64), *(const i32x4*)(kp + (size_t)(32 * kh) * 64 + 16), 0, 1, 2, 3, 4, 5, 6, 7);
    for (int t = kh; t < nt; t += 4) {
        const int tn = (t + 4 < nt) ? t + 4 : t;
        const i32x8 na = __builtin_shufflevector(*(const i32x4*)(kp + (size_t)(32 * tn) * 64), *(const i32x4*)(kp + (size_t)(32 * tn) * 64 + 16), 0, 1, 2, 3, 4, 5, 6, 7);
        __builtin_amdgcn_sched_barrier(0);
        f32x2 s[8];
#pragma unroll
        for (int i = 0; i < 8; ++i) s[i] = (f32x2){0.f, 0.f};
#pragma unroll
        for (int h = 0; h < 16; ++h) {
            const f32x16 acc = __builtin_amdgcn_mfma_scale_f32_32x32x64_f8f6f4(a, qf[h], f32x16{}, 0, 0, 0, 0, 0, 0);
#pragma unroll
            for (int i = 0; i < 8; ++i) {
                const float x0 = acc[2 * i], x1 = acc[2 * i + 1]; const int i0 = (int)__float_as_uint(x0), i1 = (int)__float_as_uint(x1);
                const float r0 = __uint_as_float((unsigned)(i0 > 0 ? i0 : 0)), r1 = __uint_as_float((unsigned)(i1 > 0 ? i1 : 0));
                s[i] = __builtin_elementwise_fma((f32x2){r0, r1}, (f32x2){w[h], w[h]}, s[i]); }
        }
#pragma unroll
        for (int a4 = 0; a4 < 4; ++a4) *(u32x2*)(srow + 32 * t + 8 * a4) = (u32x2){sortable_pk(s[2 * a4][0], s[2 * a4][1]), sortable_pk(s[2 * a4 + 1][0], s[2 * a4 + 1][1])};
        a = na;
    }
}
__device__ __forceinline__ void indexer_phase(const Frame& F) {
    for (int it = F.wg; it < 256; it += F.G) { const int b = it >> 7, j = it & 127; indexer_chunk(F, b, j); indexer_chunk(F, b, 255 - j); }
}
__device__ __forceinline__ int wave_excl_suffix(int v, int lane) {
    int x = v;
#pragma unroll
    for (int d = 1; d < 64; d <<= 1) { const int y = __shfl_down(x, d); if (lane + d < 64) x += y; }
    return x - v;
}
__device__ __forceinline__ int wave_excl_prefix(int v, int lane) {
    int x = v;
#pragma unroll
    for (int d = 1; d < 64; d <<= 1) { const int y = __shfl_up(x, d); if (lane >= d) x += y; }
    return x - v;
}
__device__ __forceinline__ void hist_find(LAS unsigned* hist, int need, int lane, int& bin, int& above, int& inbin) {
    const u32x4 q0 = *(const LAS u32x4*)(hist + 16 * lane), q1 = *(const LAS u32x4*)(hist + 16 * lane + 4), q2 = *(const LAS u32x4*)(hist + 16 * lane + 8), q3 = *(const LAS u32x4*)(hist + 16 * lane + 12);
    const int c0 = (int)(q0.x + q0.y + q0.z + q0.w), c1 = (int)(q1.x + q1.y + q1.z + q1.w), c2 = (int)(q2.x + q2.y + q2.z + q2.w), c3 = (int)(q3.x + q3.y + q3.z + q3.w);
    const int A = wave_excl_suffix(c0 + c1 + c2 + c3, lane);
    int fb = -1, fa = 0, fc = 0;
    { int a = A; if (a < need && need <= a + c3) { fb = 4 * lane + 3; fa = a; fc = c3; } a += c3;
      if (a < need && need <= a + c2) { fb = 4 * lane + 2; fa = a; fc = c2; } a += c2;
      if (a < need && need <= a + c1) { fb = 4 * lane + 1; fa = a; fc = c1; } a += c1;
      if (a < need && need <= a + c0) { fb = 4 * lane + 0; fa = a; fc = c0; } }
    const unsigned long long bal = __ballot(fb >= 0);
    const int src = bal ? (int)__builtin_ctzll(bal) : 0;
    bin = __shfl(fb, src); above = __shfl(fa, src); inbin = __shfl(fc, src);
}
__device__ __forceinline__ void select_query(const Frame& F, int b, int s, LAS unsigned* hist) {
    const int lane = F.lane, c = s >> 6, L = 64 * (c + 1), G = L >> 5, Gend = 8 * ((s >> 8) + 1);
    unsigned* MK = (unsigned*)(F.ws + WS_MASK) + (size_t)b * 512 * SEQ + s;
    if (L <= 256) { for (int g = lane; g < Gend; g += 64) MK[(size_t)g * SEQ] = (g < G) ? 0xFFFFFFFFu : 0u; return; }
    const unsigned short* row = (const unsigned short*)(F.ws + WS_SC) + sc_row_off(b, s);
    u32x4 d[8][4];
#pragma unroll
    for (int j = 0; j < 8; ++j) { const int g = lane + 64 * j; const u32x4* p = (const u32x4*)(row + g * 32);
#pragma unroll
        for (int q = 0; q < 4; ++q) d[j][q] = (g < G) ? p[q] : (u32x4){0u, 0u, 0u, 0u}; }
    const int l3 = lane & 3;
#pragma unroll
    for (int z = 0; z < 4; ++z) *(LAS u32x4*)(hist + 16 * lane + 4 * z) = (u32x4){0u, 0u, 0u, 0u};
    LDS_WAIT();
#pragma unroll
    for (int j = 0; j < 8; ++j) if (64 * j < G) { if (lane + 64 * j < G) {
#pragma unroll
        for (int q = 0; q < 4; ++q)
#pragma unroll
            for (int i = 0; i < 4; ++i) { const unsigned v = d[j][q][i]; __hip_atomic_fetch_add(hist + ((v >> 6) & 0x3fcu) + l3, 1u, __ATOMIC_RELAXED, __HIP_MEMORY_SCOPE_WORKGROUP); __hip_atomic_fetch_add(hist + ((v >> 22) & 0x3fcu) + l3, 1u, __ATOMIC_RELAXED, __HIP_MEMORY_SCOPE_WORKGROUP); } } __builtin_amdgcn_sched_barrier(0); }
    LDS_WAIT();
    int b1, above1, in1; hist_find(hist, 256, lane, b1, above1, in1);
    const int need2 = 256 - above1;
    LDS_WAIT();
#pragma unroll
    for (int z = 0; z < 4; ++z) *(LAS u32x4*)(hist + 16 * lane + 4 * z) = (u32x4){0u, 0u, 0u, 0u};
    LDS_WAIT();
#pragma unroll
    for (int j = 0; j < 8; ++j) if (64 * j < G) { if (lane + 64 * j < G) {
#pragma unroll
        for (int q = 0; q < 4; ++q)
#pragma unroll
            for (int i = 0; i < 4; ++i) { const unsigned v = d[j][q][i];
                if (((v >> 8) & 0xffu) == (unsigned)b1) __hip_atomic_fetch_add(hist + ((v & 0xffu) << 2) + l3, 1u, __ATOMIC_RELAXED, __HIP_MEMORY_SCOPE_WORKGROUP);
                if ((v >> 24) == (unsigned)b1) __hip_atomic_fetch_add(hist + ((v >> 14) & 0x3fcu) + l3, 1u, __ATOMIC_RELAXED, __HIP_MEMORY_SCOPE_WORKGROUP); } } __builtin_amdgcn_sched_barrier(0); }
    LDS_WAIT();
    int b2, above2, in2; hist_find(hist, need2, lane, b2, above2, in2);
    const unsigned T = ((unsigned)b1 << 8) | (unsigned)b2;
    const int rem = need2 - above2;
    const bool all_eq = (rem >= in2);
    int base = 0;
#pragma unroll
    for (int j = 0; j < 8; ++j) if (64 * j < G) {
        const int g = lane + 64 * j; unsigned gt = 0u, eq = 0u;
#pragma unroll
        for (int q = 0; q < 4; ++q)
#pragma unroll
            for (int i = 0; i < 4; ++i) { const unsigned v = d[j][q][i], lo = v & 0xffffu, hi = v >> 16; const int bit = 8 * q + 2 * i;
                gt |= (lo > T ? 1u : 0u) << bit; gt |= (hi > T ? 1u : 0u) << (bit + 1); eq |= (lo == T ? 1u : 0u) << bit; eq |= (hi == T ? 1u : 0u) << (bit + 1); }
        if (g >= G) { gt = 0u; eq = 0u; }
        unsigned word = gt | eq;
        if (!all_eq) {
            const int cnt = __builtin_popcount(eq); const int pre = wave_excl_prefix(cnt, lane); const int tot = __shfl(pre + cnt, 63);
            int allow = rem - base - pre; allow = allow < 0 ? 0 : (allow > cnt ? cnt : allow);
            unsigned keep = 0u, mm = eq; for (int k = 0; k < allow; ++k) { const unsigned low = mm & (0u - mm); keep |= low; mm ^= low; }
            word = gt | keep; base += tot;
        }
        if (g < G) MK[(size_t)g * SEQ] = word;
        __builtin_amdgcn_sched_barrier(0);
    }
    for (int g = G + lane; g < Gend; g += 64) MK[(size_t)g * SEQ] = 0u;
}
__device__ __forceinline__ void select_phase(const Frame& F) {
    LAS unsigned* hist = (LAS unsigned*)(F.lds + F.wave * 4096);
    const int gw = F.wg * NWAVES + F.wave, NGW = F.G * NWAVES;
    (void)gw; (void)NGW;
    for (int it = F.wg; it < 256; it += F.G) { const int b = it >> 7, j = it & 127;
#pragma unroll 1
        for (int t = 0; t < 16; ++t) { const int cc = (t & 8) ? 255 - j : j; select_query(F, b, 64 * cc + (t & 7) * 8 + F.wave, hist); } }
}
__device__ __forceinline__ void ln1_router_phase(const Frame& F) {
    const float* Y = (const float*)(F.ws + WS_Y1); bf16_t* H1B = (bf16_t*)(F.ws + WS_H1B); bf16_t* H1L = (bf16_t*)(F.ws + WS_H1L);
    const float* g = F.inp(I_LN1G); const float* bb = F.inp(I_LN1B); const float* br = F.inp(I_BR);
    const int lane = F.lane, gw = F.wg * NWAVES + F.wave;
    for (int rr = 0; rr < 16; ++rr) {
        const int m = gw * 16 + rr; const float* yr = Y + (size_t)m * D + 4 * lane; f32x4 v[8]; float s = 0.f;
#pragma unroll
        for (int j = 0; j < 8; ++j) { v[j] = __builtin_nontemporal_load((const f32x4*)(yr + 256 * j)); s += (v[j][0] + v[j][1]) + (v[j][2] + v[j][3]); }
        const float mean = wave_sum(s) * (1.f / D); float s2 = 0.f;
#pragma unroll
        for (int j = 0; j < 8; ++j) { v[j] = v[j] - mean; s2 += (v[j][0] * v[j][0] + v[j][1] * v[j][1]) + (v[j][2] * v[j][2] + v[j][3] * v[j][3]); }
        const float rs = 1.f / sqrtf(wave_sum(s2) * (1.f / D) + LN_EPS);
        bf16_t* hb = H1B + (size_t)m * D + 4 * lane; bf16_t* hl = H1L + (size_t)m * D + 4 * lane; unsigned char* hf = F.ws + WS_H1F + (size_t)m * D + 4 * lane;
#pragma unroll
        for (int j = 0; j < 8; ++j) { const f32x4 y = v[j] * rs * *(const f32x4*)(g + 4 * lane + 256 * j) + *(const f32x4*)(bb + 4 * lane + 256 * j);
            const unsigned h01 = pk2(y[0], y[1]), h23 = pk2(y[2], y[3]);
            *(u32x2*)(hb + 256 * j) = (u32x2){h01, h23};
            *(unsigned*)(hf + 256 * j) = pk4_fp8(sat8(y[0] * ACT8_H1), sat8(y[1] * ACT8_H1), sat8(y[2] * ACT8_H1), sat8(y[3] * ACT8_H1));
            *(u32x2*)(hl + 256 * j) = (u32x2){pk2(y[0] - bf_lo(h01), y[1] - bf_hi(h01)), pk2(y[2] - bf_lo(h23), y[3] - bf_hi(h23))}; }
    }
    asm volatile("s_waitcnt vmcnt(0)" ::: "memory");
    const int j = lane & 15, gq = lane >> 4;
    const bf16_t* WRH = (const bf16_t*)(F.ws + WS_WRH); const bf16_t* WRL = (const bf16_t*)(F.ws + WS_WRL);
    const bf16_t* ah = H1B + (size_t)(gw * 16 + j) * D + gq * 8; const bf16_t* al = H1L + (size_t)(gw * 16 + j) * D + gq * 8;
    const bf16_t* wh0 = WRH + (size_t)j * D + gq * 8; const bf16_t* wl0 = WRL + (size_t)j * D + gq * 8;
    f32x4 acc0 = {0.f, 0.f, 0.f, 0.f}, acc1 = {0.f, 0.f, 0.f, 0.f};
#pragma unroll 4
    for (int ks = 0; ks < 64; ++ks) {
        const bf16x8 hh = __builtin_nontemporal_load((const bf16x8*)(ah + ks * 32)), hl2 = __builtin_nontemporal_load((const bf16x8*)(al + ks * 32));
        const bf16x8 w0h = *(const bf16x8*)(wh0 + ks * 32), w1h = *(const bf16x8*)(wh0 + 16 * D + ks * 32), w0l = *(const bf16x8*)(wl0 + ks * 32), w1l = *(const bf16x8*)(wl0 + 16 * D + ks * 32);
        acc0 = __builtin_amdgcn_mfma_f32_16x16x32_bf16(w0h, hh, acc0, 0, 0, 0); acc1 = __builtin_amdgcn_mfma_f32_16x16x32_bf16(w1h, hh, acc1, 0, 0, 0);
        acc0 = __builtin_amdgcn_mfma_f32_16x16x32_bf16(w0l, hh, acc0, 0, 0, 0); acc1 = __builtin_amdgcn_mfma_f32_16x16x32_bf16(w1l, hh, acc1, 0, 0, 0);
        acc0 = __builtin_amdgcn_mfma_f32_16x16x32_bf16(w0h, hl2, acc0, 0, 0, 0); acc1 = __builtin_amdgcn_mfma_f32_16x16x32_bf16(w1h, hl2, acc1, 0, 0, 0);
    }
    float lv[8]; { const f32x4 b0 = *(const f32x4*)(br + 4 * gq), b1 = *(const f32x4*)(br + 16 + 4 * gq);
#pragma unroll
      for (int r = 0; r < 4; ++r) { lv[r] = acc0[r] + b0[r]; lv[4 + r] = acc1[r] + b1[r]; } }
    int te[4]; float tv[4];
#pragma unroll
    for (int k = 0; k < 4; ++k) {
        float bv = lv[0]; int bi = 4 * gq;
#pragma unroll
        for (int r = 1; r < 8; ++r) { const int idx = (r < 4) ? 4 * gq + r : 16 + 4 * gq + (r - 4); if (lv[r] > bv) { bv = lv[r]; bi = idx; } }
#pragma unroll
        for (int o = 16; o < 64; o <<= 1) { const float ov = __shfl_xor(bv, o); const int oi = __shfl_xor(bi, o); if (ov > bv || (ov == bv && oi < bi)) { bv = ov; bi = oi; } }
        te[k] = bi; tv[k] = bv;
#pragma unroll
        for (int r = 0; r < 8; ++r) { const int idx = (r < 4) ? 4 * gq + r : 16 + 4 * gq + (r - 4); if (idx == bi) lv[r] = -__builtin_inff(); }
    }
    const float e1 = __expf(tv[1] - tv[0]), e2 = __expf(tv[2] - tv[0]), e3 = __expf(tv[3] - tv[0]); const float inv = 1.f / (1.f + e1 + e2 + e3);
    const int m = gw * 16 + j;
    if (gq == 0) { *(int4*)((int*)(F.ws + WS_TOPE) + (size_t)m * 4) = make_int4(te[0], te[1], te[2], te[3]); *(f32x4*)((float*)(F.ws + WS_TOPG) + (size_t)m * 4) = (f32x4){inv, e1 * inv, e2 * inv, e3 * inv}; }
    int cnt = 0;
#pragma unroll 4
    for (int e = 0; e < 32; ++e) { const unsigned long long bal = __ballot(gq == 0 && (te[0] == e || te[1] == e || te[2] == e || te[3] == e)); if (lane == e) cnt = __builtin_popcountll(bal); }
    if (lane < 32) ((int*)(F.ws + WS_WVCNT))[gw * 32 + lane] = cnt;
}
__device__ __forceinline__ void moe_assign_phase(const Frame& F) {
    const int* WV = (const int*)(F.ws + WS_WVCNT); int* EI = (int*)(F.ws + WS_EXPINFO);
    LAS int* part_all = (LAS int*)F.lds;
    LAS int* part_bef = part_all + 512;
    LAS int* tot = part_bef + 512;
    LAS int* bef = tot + 32;
    LAS int* pst = bef + 32;
    LAS int* wbase = pst + 32;
    const int tid = F.tid, e = tid & 31, part = tid >> 5, gw0 = F.wg * NWAVES;
    { int a = 0, bfr = 0; for (int w = part * 128; w < part * 128 + 128; ++w) { const int v = WV[w * 32 + e]; a += v; if (w < gw0) bfr += v; } part_all[part * 32 + e] = a; part_bef[part * 32 + e] = bfr; }
    __syncthreads();
    if (tid < 32) { int a = 0, bfr = 0; for (int p = 0; p < 16; ++p) { a += part_all[p * 32 + tid]; bfr += part_bef[p * 32 + tid]; } tot[tid] = a; bef[tid] = bfr;
        const int padded = (a + 255) & ~255; int x = padded;
#pragma unroll
        for (int d = 1; d < 32; d <<= 1) { const int y = __shfl_up(x, d); if (tid >= d) x += y; }
        pst[tid] = x - padded;
        if (F.wg == 0) { const int nb0 = (x - padded) >> 8, nb1 = x >> 8; for (int bk = nb0; bk < nb1; ++bk) EI[64 + bk] = tid; if (tid == 31) EI[0] = nb1; } }
    __syncthreads();
    if (tid < 256) { const int w = tid >> 5; int a = pst[e] + bef[e]; for (int w2 = 0; w2 < w; ++w2) a += WV[(gw0 + w2) * 32 + e]; wbase[w * 32 + e] = a; }
    __syncthreads();
    int* ROWTOK = (int*)(F.ws + WS_ROWTOK); float* ROWW = (float*)(F.ws + WS_ROWW); int* SLOT = (int*)(F.ws + WS_SLOT);
    if (F.wg < 32 && tid < 256) { const int ex = F.wg, a = tot[ex], p0 = pst[ex] + a, p1 = pst[ex] + ((a + 255) & ~255); if (p0 + tid < p1) { ROWTOK[p0 + tid] = 0; ROWW[p0 + tid] = 0.f; } }
    { const int lane = F.lane, m = (gw0 + F.wave) * 16 + (lane >> 2), k = lane & 3;
      const int ex = ((const int*)(F.ws + WS_TOPE))[(size_t)m * 4 + k]; const float gt = ((const float*)(F.ws + WS_TOPG))[(size_t)m * 4 + k];
      int rank = 0;
#pragma unroll 4
      for (int q = 0; q < 32; ++q) { const unsigned long long bal = __ballot(ex == q); if (ex == q) rank = __builtin_popcountll(bal & ((1ull << lane) - 1ull)); }
      const int dest = wbase[F.wave * 32 + ex] + rank;
      ROWTOK[dest] = m; ROWW[dest] = gt; SLOT[(size_t)m * 4 + k] = dest; }
    __syncthreads();
}
__device__ __forceinline__ void final_phase(const Frame& F, bool poison, float oscale) {
    const bf16_t* H1B = (const bf16_t*)(F.ws + WS_H1B); const unsigned char* OW = F.ws + WS_OW; const bf16_t* PLE = (const bf16_t*)(F.ws + WS_PLE); const int* SLOT = (const int*)(F.ws + WS_SLOT);
    const float* g = F.inp(I_LN2G); const float* bb = F.inp(I_LN2B); const int lane = F.lane, gw = F.wg * NWAVES + F.wave, NGW = F.G * NWAVES;
    for (int m = gw; m < M; m += NGW) {
        const int4 sl = *(const int4*)(SLOT + (size_t)m * 4);
        f32x4 v[8]; float s = 0.f;
#pragma unroll
        for (int j = 0; j < 8; ++j) {
            const u32x2 hh = __builtin_nontemporal_load((const u32x2*)(H1B + (size_t)m * D + 4 * lane + 256 * j));
            f32x4 a = (f32x4){bf_lo(hh.x), bf_hi(hh.x), bf_lo(hh.y), bf_hi(hh.y)} * DN_ALPHA;
            const u32x2 p = __builtin_nontemporal_load((const u32x2*)(PLE + (size_t)m * D + 4 * lane + 256 * j));
            const int o0 = (int)__builtin_nontemporal_load((const unsigned*)(OW + (size_t)sl.x * D + 4 * lane + 256 * j)), o1 = (int)__builtin_nontemporal_load((const unsigned*)(OW + (size_t)sl.y * D + 4 * lane + 256 * j));
            const int o2 = (int)__builtin_nontemporal_load((const unsigned*)(OW + (size_t)sl.z * D + 4 * lane + 256 * j)), o3 = (int)__builtin_nontemporal_load((const unsigned*)(OW + (size_t)sl.w * D + 4 * lane + 256 * j));
            const f32x2_t e01 = (__builtin_amdgcn_cvt_pk_f32_fp8(o0, false) + __builtin_amdgcn_cvt_pk_f32_fp8(o1, false)) + (__builtin_amdgcn_cvt_pk_f32_fp8(o2, false) + __builtin_amdgcn_cvt_pk_f32_fp8(o3, false));
            const f32x2_t e23 = (__builtin_amdgcn_cvt_pk_f32_fp8(o0, true) + __builtin_amdgcn_cvt_pk_f32_fp8(o1, true)) + (__builtin_amdgcn_cvt_pk_f32_fp8(o2, true) + __builtin_amdgcn_cvt_pk_f32_fp8(o3, true));
            a[0] += e01[0] * (1.0f / OW8_SCALE) + bf_lo(p.x); a[1] += e01[1] * (1.0f / OW8_SCALE) + bf_hi(p.x);
            a[2] += e23[0] * (1.0f / OW8_SCALE) + bf_lo(p.y); a[3] += e23[1] * (1.0f / OW8_SCALE) + bf_hi(p.y);
            v[j] = a; s += (a[0] + a[1]) + (a[2] + a[3]); }
        const float mean = wave_sum(s) * (1.f / D); float s2 = 0.f;
#pragma unroll
        for (int j = 0; j < 8; ++j) { v[j] = v[j] - mean; s2 += (v[j][0] * v[j][0] + v[j][1] * v[j][1]) + (v[j][2] * v[j][2] + v[j][3] * v[j][3]); }
        const float rs = 1.f / sqrtf(wave_sum(s2) * (1.f / D) + LN_EPS);
        float* orow = F.out + (size_t)m * D + 4 * lane;
#pragma unroll
        for (int j = 0; j < 8; ++j) { f32x4 y = v[j] * rs * *(const f32x4*)(g + 4 * lane + 256 * j) + *(const f32x4*)(bb + 4 * lane + 256 * j);
            y = y * oscale;
            if (poison) y = (f32x4){__builtin_nanf(""), __builtin_nanf(""), __builtin_nanf(""), __builtin_nanf("")};
            __builtin_nontemporal_store(y, (f32x4*)(orow + 256 * j)); }
    }
}
namespace att {
constexpr int Dh = 128, NW = 8, QBLK = 32, KVBLK = 64, QB = NW * QBLK;
constexpr int SHM_K = KVBLK * Dh, SHM_V = Dh * KVBLK;
constexpr int BIAS_OFF = 2 * SHM_V + 2 * SHM_K + NW * 64 * 4;
constexpr int PEN_OFF = BIAS_OFF + 8 * 256 * 4;
constexpr int ATT_LDS = PEN_OFF + 256;
constexpr float QKV8 = QKV8_SCALE;
constexpr float SCALE = ATT_SCALE / (QKV8 * QKV8), THR = 2.f;
constexpr float PEXP = 5.f;
#define SBAR() __builtin_amdgcn_sched_barrier(0)
__device__ __forceinline__ int crow(int r, int hi) { return (r & 3) + 8 * (r >> 2) + 4 * hi; }

__device__ __forceinline__ void mask_tile(f32x16& p0, f32x16& p1, unsigned w0, unsigned w1) {
#pragma unroll
    for (int r = 0; r < 16; ++r) { const int c = (r & 3) + 8 * (r >> 2);
        const unsigned m0 = (unsigned)((int)(w0 << (31 - c)) >> 31), m1 = (unsigned)((int)(w1 << (31 - c)) >> 31);
        p0[r] = __uint_as_float((__float_as_uint(p0[r]) & m0) | (0xFF800000u & ~m0));
        p1[r] = __uint_as_float((__float_as_uint(p1[r]) & m1) | (0xFF800000u & ~m1)); }
}
__device__ __forceinline__ void bias_tile(f32x16& p0, f32x16& p1, const LAS float* tab, int rel0) {
#pragma unroll
    for (int r = 0; r < 16; ++r) { const int c = (r & 3) + 8 * (r >> 2); int i0 = rel0 + c, i1 = rel0 + c + 32;
        i0 = i0 < 0 ? 0 : (i0 > 255 ? 255 : i0); i1 = i1 < 0 ? 0 : (i1 > 255 ? 255 : i1);
        p0[r] += tab[i0]; p1[r] += tab[i1]; }
}
__device__ __forceinline__ void partialSM(f32x16& p0, f32x16& p1, float& m_reg, float& mn, float& alpha) {
    float pmax = p0[0];
#pragma unroll
    for (int r = 1; r < 16; ++r) pmax = fmaxf(pmax, p0[r]);
#pragma unroll
    for (int r = 0; r < 16; ++r) pmax = fmaxf(pmax, p1[r]);
    { auto rr = __builtin_amdgcn_permlane32_swap(__float_as_uint(pmax), __float_as_uint(pmax), false, false);
      pmax = fmaxf(__uint_as_float(rr[0]), __uint_as_float(rr[1])); }
    constexpr float C2 = 1.4426950408889634f * SCALE;
    if (__builtin_expect(__all((pmax - m_reg) * SCALE <= THR), 1)) { mn = m_reg; alpha = 1.f; }
    else { mn = fmaxf(m_reg, pmax); alpha = __builtin_amdgcn_exp2f((m_reg - mn) * C2); m_reg = mn; }
    const float mnL = -mn * C2 + PEXP;
#pragma unroll
    for (int r = 0; r < 16; r += 2) { const f32x2 v = __builtin_elementwise_fma((f32x2){p0[r], p0[r + 1]}, (f32x2){C2, C2}, (f32x2){mnL, mnL}); p0[r] = v[0]; p0[r + 1] = v[1]; }
#pragma unroll
    for (int r = 0; r < 16; r += 2) { const f32x2 v = __builtin_elementwise_fma((f32x2){p1[r], p1[r + 1]}, (f32x2){C2, C2}, (f32x2){mnL, mnL}); p1[r] = v[0]; p1[r + 1] = v[1]; }
#pragma unroll
    for (int r = 0; r < 16; ++r) p0[r] = __builtin_amdgcn_exp2f(p0[r]);
}
__device__ __forceinline__ void finishSM(f32x16& p0, f32x16& p1, float alpha, float& l_reg, i32x8& pa) {
#pragma unroll
    for (int r = 0; r < 16; ++r) p1[r] = __builtin_amdgcn_exp2f(p1[r]);
    f32x2 sa = {p0[0], p0[1]}, sb = {p1[0], p1[1]};
#pragma unroll
    for (int r = 2; r < 16; r += 2) { sa += (f32x2){p0[r], p0[r + 1]}; sb += (f32x2){p1[r], p1[r + 1]}; }
    sa += sb;
    float ps = sa[0] + sa[1];
    { auto rr = __builtin_amdgcn_permlane32_swap(__float_as_uint(ps), __float_as_uint(ps), false, false);
      ps = __uint_as_float(rr[0]) + __uint_as_float(rr[1]); }
    l_reg = l_reg * alpha + ps;
#pragma unroll
    for (int w = 0; w < 4; ++w) { pa[w] = (int)pk4_fp8(p0[4 * w], p0[4 * w + 1], p0[4 * w + 2], p0[4 * w + 3]); pa[4 + w] = (int)pk4_fp8(p1[4 * w], p1[4 * w + 1], p1[4 * w + 2], p1[4 * w + 3]); }
}
__device__ __forceinline__ i32x8 cat8(const i32x4 lo, const i32x4 hi) { return __builtin_shufflevector(lo, hi, 0, 1, 2, 3, 4, 5, 6, 7); }
template <int KB>
__device__ __forceinline__ void qkt(f32x16& p0, f32x16& p1, const char* K_lds, int r32, int hi, const i32x8* qr, unsigned w0, unsigned w1, const char* pen) {
#pragma unroll
    for (int g = 0; g < 4; ++g) { const f32x4 e0 = *reinterpret_cast<const f32x4*>(pen + (((w0 >> (8 * g)) & 15u) << 4)), e1 = *reinterpret_cast<const f32x4*>(pen + (((w1 >> (8 * g)) & 15u) << 4));
        p0[4 * g] = e0[0]; p0[4 * g + 1] = e0[1]; p0[4 * g + 2] = e0[2]; p0[4 * g + 3] = e0[3]; p1[4 * g] = e1[0]; p1[4 * g + 1] = e1[1]; p1[4 * g + 2] = e1[2]; p1[4 * g + 3] = e1[3]; }
    const char* a = K_lds + KB * SHM_K + r32 * 128; const int sw = r32 & 7;
#pragma unroll
    for (int s = 0; s < 2; ++s) { const int c0 = ((4 * s + 2 * hi) ^ sw) << 4, c1 = ((4 * s + 2 * hi + 1) ^ sw) << 4;
        const i32x8 k0 = cat8(*reinterpret_cast<const i32x4*>(a + c0), *reinterpret_cast<const i32x4*>(a + c1));
        const i32x8 k1 = cat8(*reinterpret_cast<const i32x4*>(a + 32 * 128 + c0), *reinterpret_cast<const i32x4*>(a + 32 * 128 + c1));
        p0 = __builtin_amdgcn_mfma_scale_f32_32x32x64_f8f6f4(k0, qr[s], p0, 0, 0, 0, 0, 0, 0);
        p1 = __builtin_amdgcn_mfma_scale_f32_32x32x64_f8f6f4(k1, qr[s], p1, 0, 0, 0, 0, 0, 0); }
}
template <int VB>
__device__ __forceinline__ void pv_tile(f32x16* o, const char* V_lds, int r32, int hi, const i32x8 pa) {
#pragma unroll
    for (int db = 0; db < 4; ++db) { const int d = 32 * db + r32, sw = (d >> 1) & 3; const char* a = V_lds + VB * SHM_V + d * 64;
        const i32x8 v = cat8(*reinterpret_cast<const i32x4*>(a + (((2 * hi) ^ sw) << 4)), *reinterpret_cast<const i32x4*>(a + (((2 * hi + 1) ^ sw) << 4)));
        o[db] = __builtin_amdgcn_mfma_scale_f32_32x32x64_f8f6f4(pa, v, o[db], 0, 0, 0, 0, 0, 0); }
}
struct BlockRef { const unsigned char* Q; const unsigned char* K; const unsigned char* VT; unsigned char* O; const unsigned* MK; int P0; int hd; };
struct Seam { i32x8 qr[2]; u32x4 st_k, st_v; };
#define VMW() asm volatile("s_waitcnt vmcnt(0)" ::: "memory")
#define VMWN(n) asm volatile("s_waitcnt vmcnt(%0)" :: "i"(n) : "memory")
#define SLOAD_H(Kp, Vp, k0) do { S.st_v = *reinterpret_cast<const u32x4*>((Vp) + (size_t)((k0) >> 6) * 8192 + vsrc); S.st_k = *reinterpret_cast<const u32x4*>((Kp) + (size_t)(k0) * 128 + ksrc); } while (0)
#define SWRITE_HK(bf) do { *(u32x4*)(K_lds + (bf) * SHM_K + kws) = S.st_k; } while (0)
#define SWRITE_HV(bf) do { *(u32x4*)(V_lds + (bf) * SHM_V + vws) = S.st_v; } while (0)
#define SWRITE_H(bf) do { SWRITE_HV(bf); SWRITE_HK(bf); } while (0)
#define QLOAD(ref) do { _Pragma("unroll") for (int s_ = 0; s_ < 2; ++s_) { const unsigned char* qp_ = (ref).Q + (size_t)(wid * QBLK + r32) * 128 + 64 * s_ + 32 * hi; \
        S.qr[s_] = cat8(*reinterpret_cast<const i32x4*>(qp_), *reinterpret_cast<const i32x4*>(qp_ + 16)); } } while (0)
#define MLOAD(ref, t, W0, W1) do { const unsigned* mp_ = (ref).MK + (size_t)(2 * (t)) * SEQ + wid * QBLK + r32; W0 = mp_[0]; W1 = mp_[SEQ]; } while (0)
#define ATT_TID() int tid = threadIdx.x; asm volatile("" : "+v"(tid)); \
    const int wid = __builtin_amdgcn_readfirstlane(tid >> 6), lane = tid & 63, r32 = lane & 31, hi = lane >> 5; (void)lane; \
    const int kr = tid >> 3, kc = tid & 7, ksrc = kr * 128 + kc * 16, kws = kr * 128 + ((kc ^ (kr & 7)) << 4); \
    const int vd = tid >> 2, vc = tid & 3, vsrc = vd * 64 + vc * 16, vws = vd * 64 + ((vc ^ ((vd >> 1) & 3)) << 4)
__device__ __forceinline__ void prime(const BlockRef& cur, char* lds, Seam& S) {
    ATT_TID(); (void)vws; char* K_lds = lds + 2 * SHM_V;
    QLOAD(cur);
    SLOAD_H(cur.K, cur.VT, 0); VMW(); SWRITE_HK(0);
    __syncthreads();
}
__device__ __forceinline__ void block(const BlockRef& cur, const BlockRef& nxt, char* lds, Seam& S) {
    ATT_TID();
    const int NT = cur.P0 / KVBLK + 4;
    const int qlo = cur.P0 + wid * QBLK, qpos = qlo + r32;
    char* V_lds = lds; char* K_lds = lds + 2 * SHM_V;
    float* ws = (float*)(lds + 2 * SHM_V + 2 * SHM_K) + wid * 64; float* li_l = ws, * al_l = ws + 32;
    const LAS float* btab = (const LAS float*)(lds + BIAS_OFF) + cur.hd * 256; const char* pen = lds + PEN_OFF;
    float m_reg = -1e30f, l_reg = 0; f32x16 o[4] = {};
    const unsigned char* Kh = cur.K; const unsigned char* Vh = cur.VT;
    unsigned mkA0, mkA1, mkB0, mkB1;
    MLOAD(cur, 0, mkA0, mkA1);
#define RESC(a) do { if (__any((a) < 1.f)) { if (hi == 0) al_l[r32] = (a); asm volatile("s_waitcnt lgkmcnt(0)" ::: "memory");              \
                     for (int d_ = 0; d_ < 4; ++d_) for (int r = 0; r < 16; ++r) o[d_][r] *= al_l[crow(r, hi)]; } } while (0)
#define KBASE(t) ((t) * KVBLK)
#define MASKT(P0_, P1_, t, W0, W1) do { const int kb_ = KBASE(t); if (kb_ + KVBLK - 1 > qlo - 160) bias_tile(P0_, P1_, btab, kb_ + 4 * hi - qpos + 192); } while (0)
    f32x16 pA0, pA1, pB0, pB1; float mnA, mnB, alA, alB; i32x8 pa;
    u32x4 ak, av, bk, bv;
#define GLOAD(SK, SV, k0) do { SV = *reinterpret_cast<const u32x4*>(Vh + (size_t)((k0) >> 6) * 8192 + vsrc); SK = *reinterpret_cast<const u32x4*>(Kh + (size_t)(k0) * 128 + ksrc); } while (0)
#define LWRITE(SK, SV, bf) do { *(u32x4*)(V_lds + (bf) * SHM_V + vws) = SV; *(u32x4*)(K_lds + (bf) * SHM_K + kws) = SK; } while (0)
    SWRITE_HV(0); SBAR();
    MLOAD(cur, 1, mkB0, mkB1); GLOAD(bk, bv, KBASE(1)); GLOAD(ak, av, KBASE(2));
    SBAR(); qkt<0>(pA0, pA1, K_lds, r32, hi, S.qr, mkA0 >> (4 * hi), mkA1 >> (4 * hi), pen);
    MASKT(pA0, pA1, 0, mkA0, mkA1); partialSM(pA0, pA1, m_reg, mnA, alA);
    LWRITE(bk, bv, 1);
    __syncthreads();
#define HALF_STEP(PX0, PX1, mnX, alX, PY0, PY1, alY, t, KB, VB, SB, WX0, WX1, WN0, WN1, LK, LV, WK, WV) do {                                  \
        SBAR(); qkt<KB>(PX0, PX1, K_lds, r32, hi, S.qr, (WX0) >> (4 * hi), (WX1) >> (4 * hi), pen);                                           \
        finishSM(PY0, PY1, alY, l_reg, pa); SBAR();                                                           \
        if ((t) + 2 < NT) { GLOAD(LK, LV, KBASE((t) + 2)); SBAR(); }                                                           \
        pv_tile<VB>(o, V_lds, r32, hi, pa); MASKT(PX0, PX1, (t), WX0, WX1); if ((t) + 1 < NT) MLOAD(cur, (t) + 1, WN0, WN1); partialSM(PX0, PX1, m_reg, mnX, alX);              \
        __syncthreads();                                                                                                      \
        if ((t) + 1 < NT) { LWRITE(WK, WV, SB); }                                                                          \
        RESC(alX); __syncthreads(); } while (0)
    for (int t = 1; t + 1 < NT; t += 2) {
        HALF_STEP(pB0, pB1, mnB, alB, pA0, pA1, alA, t, 1, 0, 0, mkB0, mkB1, mkA0, mkA1, bk, bv, ak, av);
        HALF_STEP(pA0, pA1, mnA, alA, pB0, pB1, alB, t + 1, 0, 1, 1, mkA0, mkA1, mkB0, mkB1, ak, av, bk, bv);
    }
#undef GLOAD
#undef LWRITE
    SBAR(); qkt<1>(pB0, pB1, K_lds, r32, hi, S.qr, mkB0 >> (4 * hi), mkB1 >> (4 * hi), pen); SBAR();
    SLOAD_H(nxt.K, nxt.VT, 0); SBAR();
    QLOAD(nxt);
    SBAR();
    finishSM(pA0, pA1, alA, l_reg, pa); SBAR();
    pv_tile<0>(o, V_lds, r32, hi, pa);
    MASKT(pB0, pB1, NT - 1, mkB0, mkB1); partialSM(pB0, pB1, m_reg, mnB, alB); __syncthreads(); RESC(alB);
    finishSM(pB0, pB1, alB, l_reg, pa); SBAR(); pv_tile<1>(o, V_lds, r32, hi, pa);
    SBAR(); VMWN(4); SWRITE_HK(0); SBAR();
    if (hi == 0) li_l[r32] = l_reg; asm volatile("s_waitcnt lgkmcnt(0)" ::: "memory");
    float rli[16];
#pragma unroll
    for (int r = 0; r < 16; ++r) rli[r] = __builtin_amdgcn_rcpf(li_l[crow(r, hi)]);
    int loff = hi * 4096 + r32; asm volatile("" : "+v"(loff));
    unsigned char* Ow = cur.O + (size_t)(wid * QBLK) * 1024 + loff;
#pragma unroll
    for (int r = 0; r < 16; ++r) { const int orow = (r & 3) + 8 * (r >> 2);
#pragma unroll
        for (int d0 = 0; d0 < 4; ++d0) { const float v = o[d0][r] * rli[r];
            const int vi = (int)__float_as_uint(v);
            const float v1 = __uint_as_float((unsigned)__builtin_amdgcn_mov_dpp(vi, 0x39, 0xf, 0xf, true)), v2 = __uint_as_float((unsigned)__builtin_amdgcn_mov_dpp(vi, 0x4e, 0xf, 0xf, true)), v3 = __uint_as_float((unsigned)__builtin_amdgcn_mov_dpp(vi, 0x93, 0xf, 0xf, true));
            if ((r32 & 3) == 0) *(unsigned*)(Ow + (size_t)orow * 1024 + d0 * 32) = pk4_fp8(sat8(v), sat8(v1), sat8(v2), sat8(v3)); } }
    __syncthreads();
#undef RESC
#undef KBASE
#undef MASKT
#undef HALF_STEP
}
#undef VMW
#undef VMWN
#undef SLOAD_H
#undef SWRITE_HK
#undef SWRITE_HV
#undef SWRITE_H
#undef QLOAD
#undef MLOAD
#undef ATT_TID
}

__device__ __forceinline__ int t5_bucket(int rel) {
    const int n = rel < 0 ? -rel : rel; const int base = rel > 0 ? 16 : 0;
    if (n < 8) return base + n;
    int lg = 2 + (31 - __builtin_clz((unsigned)(n * n))); if (lg > 15) lg = 15;
    return base + lg;
}
__device__ __forceinline__ void attention_phase(const Frame& F) {
    char* lds = (char*)(uintptr_t)0;
    (void)lds;
    char* shm = (char*)F.lds;
    { const float* rb = F.inp(I_RELB); LAS float* tab = (LAS float*)(F.lds + att::BIAS_OFF);
      if (F.tid < 64) ((LAS float*)(F.lds + att::PEN_OFF))[F.tid] = ((F.tid >> 2) >> (F.tid & 3)) & 1 ? 0.f : -__builtin_inff();
      for (int i = F.tid; i < 8 * 256; i += NTHR) { const int h = i >> 8, rel = (i & 255) - 192; tab[i] = (rb[t5_bucket(rel) * 8 + h] - rb[15 * 8 + h]) * (1.0f / att::SCALE); } }
    __syncthreads();
    const unsigned char* Qb = F.ws + WS_Q; const unsigned char* Kb = F.ws + WS_K; const unsigned char* Vb = F.ws + WS_V;
    unsigned char* ATT = F.ws + WS_ATT; const unsigned* MKb = (const unsigned*)(F.ws + WS_MASK);
    const int xcd = F.wg & 7, idx = F.wg >> 3;
    auto mkref = [&](int blk) -> att::BlockRef {
        const int round = blk >> 1, pass = blk & 1, bh = round * 8 + xcd, b = bh >> 3, h = bh & 7, qb = pass ? idx : 63 - idx;
        att::BlockRef r; const size_t hb = ((size_t)h * M + (size_t)b * SEQ) * 128;
        r.Q = Qb + hb + (size_t)qb * 256 * 128; r.K = Kb + hb; r.VT = Vb + hb; r.O = ATT + ((size_t)b * SEQ + (size_t)qb * 256) * 1024 + h * 128;
        r.MK = MKb + (size_t)b * 512 * SEQ + qb * 256; r.P0 = qb * 256; r.hd = h; return r; };
    att::Seam S;
    att::BlockRef cur = mkref(0);
    att::prime(cur, shm, S);
#pragma unroll 1
    for (int blk = 0; blk < 4; ++blk) {
        const att::BlockRef nxt = mkref(blk < 3 ? blk + 1 : blk);
        att::block(cur, nxt, shm, S);
        cur = nxt;
    }
    VM_WAIT(); __syncthreads();
}
#ifdef SELFCHECK
constexpr int CW_EATT = 8192, CW_ECNT = 8256, CW_ESEL = 8320;
__device__ __forceinline__ float wave_max(float v) {
#pragma unroll
    for (int o = 1; o < 64; o <<= 1) v = fmaxf(v, __shfl_xor(v, o));
    return v;
}
__device__ __forceinline__ float wave_min(float v) {
#pragma unroll
    for (int o = 1; o < 64; o <<= 1) v = fminf(v, __shfl_xor(v, o));
    return v;
}
__device__ __forceinline__ float bfv(const bf16_t* p) { return __builtin_bit_cast(float, (unsigned)(*p) << 16); }
__device__ __forceinline__ float f8v(const unsigned char* p) { const int w = (int)(*p); return __builtin_amdgcn_cvt_f32_fp8(w, 0) * (1.0f / QKV8_SCALE); }
__device__ __forceinline__ void selfcheck_phase(const unsigned char* ws, const float* relb, unsigned* ctl, int wg, int wave, int lane, LAS unsigned char* lds) {
    const int gw = wg * 8 + wave;
    const int b = gw & 1, h = (gw >> 1) & 7;
    int s = (int)(((unsigned)gw * 2654435761u) >> 9) & (SEQ - 1);
    if (gw < 128) s = gw * 3;
    if (gw >= 128 && gw < 160) s = SEQ - 1 - (gw - 128) * 7;
    const int m = b * SEQ + s, L = 64 * ((s >> 6) + 1), G = L >> 5, Gend = 8 * ((s >> 8) + 1);
    const unsigned* MK = (const unsigned*)(ws + WS_MASK) + (size_t)b * 512 * SEQ + s;
    int cnt = 0, badbits = 0;
    for (int g = lane; g < Gend; g += 64) { const unsigned w = MK[(size_t)g * SEQ]; if (g < G) cnt += __builtin_popcount(w); else badbits += (w != 0u); }
    cnt = (int)wave_sum((float)cnt); badbits = (int)wave_sum((float)badbits);
    const int want = L < 256 ? L : 256;
    if (lane == 0 && (cnt != want || badbits != 0)) atomicAdd(ctl + CW_ECNT, 1u);
    const unsigned char* Qh = ws + WS_Q + ((size_t)h * M + m) * 128; const unsigned char* Kh = ws + WS_K + ((size_t)h * M + (size_t)b * SEQ) * 128; const unsigned char* Vh = ws + WS_V + ((size_t)h * M + (size_t)b * SEQ) * 128;
    const float q0 = f8v(Qh + 2 * lane), q1 = f8v(Qh + 2 * lane + 1);
    float mrun = -1e30f, lrun = 0.f, o0 = 0.f, o1 = 0.f;
    for (int g = 0; g < G; ++g) {
        unsigned w = MK[(size_t)g * SEQ];
        while (w) { const int bit = __builtin_ctz(w); w &= w - 1u; const int kk = 32 * g + bit;
            const float dot = wave_sum(q0 * f8v(Kh + (size_t)kk * 128 + 2 * lane) + q1 * f8v(Kh + (size_t)kk * 128 + 2 * lane + 1));
            const unsigned char* vt = Vh + (size_t)(kk & ~63) * 128 + vt_pos(kk & 63);
            const float lg = dot * ATT_SCALE + relb[t5_bucket(kk - s) * 8 + h];
            const float mn = fmaxf(mrun, lg), al = __expf(mrun - mn), p = __expf(lg - mn);
            lrun = lrun * al + p; o0 = o0 * al + p * f8v(vt + (2 * lane) * 64); o1 = o1 * al + p * f8v(vt + (2 * lane + 1) * 64); mrun = mn; }
    }
    o0 /= lrun; o1 /= lrun;
    const unsigned char* At = ws + WS_ATT + (size_t)m * 1024 + h * 128;
    const float a0 = f8v(At + 2 * lane), a1 = f8v(At + 2 * lane + 1);
    const float num = wave_sum((o0 - a0) * (o0 - a0) + (o1 - a1) * (o1 - a1)), den = wave_sum(o0 * o0 + o1 * o1);
    const float eatt = sqrtf(num / fmaxf(den, 1e-30f));
    if (lane == 0) atomicMax(ctl + CW_EATT, __float_as_uint(fminf(eatt, 100.f)));
    if ((gw & 3) == 0 && L > 256) {
        LAS unsigned char* ql = (LAS unsigned char*)(lds + wave * 4096);
        const unsigned* QIr = (const unsigned*)(ws + WS_QI + (size_t)m * 1024);
        for (int i = lane; i < 256; i += 64) ((LAS unsigned*)ql)[i] = QIr[i];
        float wv[16];
#pragma unroll
        for (int j = 0; j < 16; ++j) wv[j] = ((const float*)(ws + WS_WI))[(size_t)m * 16 + j];
        LDS_WAIT();
        float smin = 3e38f, umax = -3e38f;
        for (int k = lane; k < L; k += 64) {
            const unsigned char* kr = ws + WS_KI + ((size_t)b * SEQ + k) * 64;
            float kd[64];
#pragma unroll
            for (int j = 0; j < 64; ++j) kd[j] = f8v(kr + j);
            float sc = 0.f;
#pragma unroll 1
            for (int hh = 0; hh < 16; ++hh) { float dot = 0.f;
#pragma unroll
                for (int j = 0; j < 64; ++j) { const int qb_ = (int)ql[hh * 64 + j]; dot = fmaf(__builtin_amdgcn_cvt_f32_fp8(qb_, 0) * (1.0f / QKV8_SCALE), kd[j], dot); }
                sc = fmaf(wv[hh], fmaxf(dot, 0.f), sc); }
            const unsigned w = MK[(size_t)(k >> 5) * SEQ];
            if ((w >> (k & 31)) & 1u) smin = fminf(smin, sc); else umax = fmaxf(umax, sc);
        }
        smin = wave_min(smin); umax = wave_max(umax);
        const float viol = fmaxf(umax - smin, 0.f) / fmaxf(fabsf(smin), 1.f);
        if (lane == 0) atomicMax(ctl + CW_ESEL, __float_as_uint(fminf(viol, 100.f)));
    }
}
#endif
#ifndef WGM_IN
#define WGM_IN 4
#endif
#ifndef WGM_N8
#define WGM_N8 4
#endif
#ifndef WGM_G1
#define WGM_G1 8
#endif
#ifndef WGM_G2
#define WGM_G2 8
#endif
#ifndef LAST_PHASE
#define LAST_PHASE 99
#endif
#ifndef PHASE_MASK
#define PHASE_MASK 0xFFFFFFFFu
#endif
#ifndef DOUBLE_MASK
#define DOUBLE_MASK 0u
#endif
#define PH(k, ...) do { if constexpr ((PHASE_MASK >> (k)) & 1u) { NEWFRAME(); __VA_ARGS__ if constexpr ((DOUBLE_MASK >> (k)) & 1u) { NEWFRAME(); __VA_ARGS__ } } } while (0)
__global__ void __launch_bounds__(NTHR, 2) fwd_kernel(Args args) {
    extern __shared__ __attribute__((aligned(16))) unsigned char lds_raw[];
#define NEWFRAME() do { int t_ = threadIdx.x; asm volatile("" : "+v"(t_)); F.tid = t_; F.lane = t_ & 63; F.wave = __builtin_amdgcn_readfirstlane(t_ >> 6); } while (0)
    Frame F;
    F.lds = (LAS unsigned char*)lds_raw; F.wg = blockIdx.x; F.G = gridDim.x;
    F.a = &args; F.out = args.out; F.ws = args.ws;
    NEWFRAME();
    volatile LAS unsigned* MISC = (volatile LAS unsigned*)(F.lds + MISC_OFF);
    if (F.tid < 32) MISC[F.tid] = 0u;
    __syncthreads();
    unsigned* ctl = (unsigned*)(F.ws + WS_CTL);
    XcdBarrier bar = xcd_barrier_post(ctl + CW_BAR, MISC + 8);
    LAS unsigned char* stage = F.lds;
    const LAS unsigned short* rowtab = (const LAS unsigned short*)(F.lds + ROWTAB_OFF);

    PH(0, p0_prologue(F););
    xcd_barrier(bar);
    if (LAST_PHASE < 1) return;
    PH(1, { pg8::StaticOrder S; S.init(M / 256, WIN8_HI - WIN8_LO, F.G, F.wg, WGM_IN);
      BWin<false> bs{(const char*)(F.ws + WS_WIN), (size_t)256 * 2048 * 2};
      EpiIn<false> E{(bf16_t*)(F.ws + WS_Q), (bf16_t*)(F.ws + WS_K), (bf16_t*)(F.ws + WS_V), (bf16_t*)(F.ws + WS_QI), (bf16_t*)(F.ws + WS_KI), (bf16_t*)(F.ws + WS_GB), (bf16_t*)(F.ws + WS_CU), (bf16_t*)(F.ws + WS_SGA), (bf16_t*)(F.ws + WS_SGB), (float*)(F.ws + WS_WI)};
      pg8::gemm_phase<EpiIn<false>, BWin<false>, false>(stage, (const bf16_t*)(F.ws + WS_HB), 2048, S, bs, E, rowtab); });
    __syncthreads();
    PH(18, { pg8::StaticOrder S; S.init(M / 256, NIN_TILES - (WIN8_HI - WIN8_LO), F.G, F.wg, WGM_IN);
      BWin<true> bs{(const char*)(F.ws + WS_WIN8), (size_t)256 * 2048};
      EpiIn<true> E{(bf16_t*)(F.ws + WS_Q), (bf16_t*)(F.ws + WS_K), (bf16_t*)(F.ws + WS_V), (bf16_t*)(F.ws + WS_QI), (bf16_t*)(F.ws + WS_KI), (bf16_t*)(F.ws + WS_GB), (bf16_t*)(F.ws + WS_CU), (bf16_t*)(F.ws + WS_SGA), (bf16_t*)(F.ws + WS_SGB), (float*)(F.ws + WS_WI)};
      pg8::gemm_phase<EpiIn<true>, BWin<true>, false>(stage, (const bf16_t*)(F.ws + WS_HB8), 1024, S, bs, E, rowtab); });
    xcd_barrier(bar);
    if (LAST_PHASE < 2) return;
    PH(2, conv_phase(F););
    PH(3, indexer_phase(F););
    asm volatile("s_waitcnt vmcnt(0)" ::: "memory"); __syncthreads();
    PH(4, select_phase(F););
    xcd_barrier(bar);
    if (LAST_PHASE < 4) return;
    PH(6, attention_phase(F););
    xcd_barrier(bar);
#ifdef SELFCHECK
    NEWFRAME(); selfcheck_phase(F.ws, F.inp(I_RELB), ctl, F.wg, F.wave, F.lane, F.lds);
    xcd_barrier(bar);
#endif
    if (LAST_PHASE < 5) return;
    PH(5, { pg8::StaticOrder S; S.init(M / 256, 8, F.G, F.wg, WGM_N8);
      BPlain bs{(const char*)(F.ws + WS_WB), (size_t)256 * 1024};
      EpiGate<false, 4> E{(const bf16_t*)(F.ws + WS_SGB), nullptr, (bf16_t*)(F.ws + WS_T2)};
      pg8::gemm_phase<EpiGate<false, 4>, BPlain, false>(stage, (const bf16_t*)(F.ws + WS_GB8), 512, S, bs, E, rowtab); });
    asm volatile("s_waitcnt vmcnt(0)" ::: "memory"); __syncthreads();
    PH(7, { pg8::StaticOrder S; S.init(M / 256, 8, F.G, F.wg, WGM_N8);
      BPlain bs{(const char*)(F.ws + WS_WA), (size_t)256 * 1024};
      EpiGate<true, 8> E{(const bf16_t*)(F.ws + WS_SGA), (const bf16_t*)(F.ws + WS_T2), (bf16_t*)(F.ws + WS_T2)};
      pg8::gemm_phase<EpiGate<true, 8>, BPlain, false>(stage, (const bf16_t*)(F.ws + WS_ATT), 512, S, bs, E, rowtab); });
    xcd_barrier(bar);
    if (LAST_PHASE < 6) return;
    PH(8, { pg8::StaticOrder S; S.init(M / 256, 8, F.G, F.wg, WGM_N8);
      BPlain bs{(const char*)(F.ws + WS_WO), (size_t)256 * 2048 * 2};
      EpiY1 E{F.inp(I_X), (const float*)(F.ws + WS_STATS), (const float*)(F.ws + WS_STATS) + M, F.inp(I_LNG), F.inp(I_LNB), (float*)(F.ws + WS_Y1)};
      pg8::gemm_phase<EpiY1, BPlain, false>(stage, (const bf16_t*)(F.ws + WS_T2), 2048, S, bs, E, rowtab); });
    xcd_barrier(bar);
    if (LAST_PHASE < 7) return;
    PH(9, ln1_router_phase(F););
    PH(10, { pg8::StaticOrder S; S.init(M / 256, 8, F.G, F.wg, WGM_N8);
      BPlain bs{(const char*)(F.ws + WS_WPP), (size_t)256 * 256 * 2};
      EpiPlain E{(bf16_t*)(F.ws + WS_PLE)};
      int kpp = 256; asm volatile("" : "+s"(kpp));
      pg8::gemm_phase<EpiPlain, BPlain, false>(stage, (const bf16_t*)(F.ws + WS_PB), kpp, S, bs, E, rowtab); });
    xcd_barrier(bar);
    if (LAST_PHASE < 8) return;
    PH(12, moe_assign_phase(F););
    { const bool gemm_first = ((F.wg >> 3) & 1) != 0;
      if (!gemm_first) { PH(11, moe_w1_convert(F);); __syncthreads(); }
      PH(13, { pg8::StaticOrder S; S.init(M / 256, 8, F.G, F.wg, WGM_N8);
        BPlain bs{(const char*)(F.ws + WS_WPG), (size_t)256 * 2048};
        EpiPle E{(bf16_t*)(F.ws + WS_PLE)};
        pg8::gemm_phase<EpiPle, BPlain, false>(stage, (const bf16_t*)(F.ws + WS_H1F), 1024, S, bs, E, rowtab); });
      __syncthreads();
      if (gemm_first) { PH(11, moe_w1_convert(F);); } }
    xcd_barrier(bar);
    if (LAST_PHASE < 9) return;
    const int* EI = (const int*)(F.ws + WS_EXPINFO);
    const int nblk = EI[0];
    const bool gemm_first9 = ((F.wg >> 3) & 1) != 0;
    if (!gemm_first9) { PH(17, moe_w2_convert(F);); __syncthreads(); }
    PH(14, { pg8::StaticOrder S; S.init(nblk, 16, F.G, F.wg, WGM_G1);
      { LAS unsigned short* rt = (LAS unsigned short*)(F.lds + ROWTAB_OFF); const int* ROWTOK = (const int*)(F.ws + WS_ROWTOK); pg8::Unit u;
        for (int i = 0; i < 34 && S.next(i, u); ++i) if (F.tid < 256) rt[i * 256 + F.tid] = (unsigned short)ROWTOK[u.pm * 256 + F.tid]; }
      __syncthreads();
      BExpert bs{(const char*)(F.ws + WS_W1), (size_t)4096 * 2048, (size_t)256 * 2048, EI + 64};
      EpiAct E{F.inp(I_BG), F.inp(I_BU), EI + 64, F.ws + WS_ACT};
      pg8::gemm_phase<EpiAct, BExpert, true>(stage, (const bf16_t*)(F.ws + WS_H1F), 1024, S, bs, E, rowtab); });
    if (gemm_first9) { __syncthreads(); PH(17, moe_w2_convert(F);); }
    xcd_barrier(bar);
    if (LAST_PHASE < 10) return;
    PH(15, { pg8::StaticOrder S; S.init(nblk, 8, F.G, F.wg, WGM_G2);
      BExpert bs{(const char*)(F.ws + WS_W2), (size_t)2048 * 2048, (size_t)256 * 2048, EI + 64};
      EpiDown E{F.inp(I_BD), EI + 64, (const float*)(F.ws + WS_ROWW), F.ws + WS_OW};
      pg8::gemm_phase<EpiDown, BExpert, false>(stage, (const bf16_t*)(F.ws + WS_ACT), 1024, S, bs, E, rowtab); });
    xcd_barrier(bar);
    if (LAST_PHASE < 11) return;
    const bool poison = __hip_atomic_load(ctl + CW_BAR + XB_TMO, RLX_AGENT) != 0u;
    float oscale = 1.0f;
#ifdef SELFCHECK
    { const float eatt = __uint_as_float(__hip_atomic_load(ctl + CW_EATT, RLX_AGENT)), esel = __uint_as_float(__hip_atomic_load(ctl + CW_ESEL, RLX_AGENT)); const unsigned ecnt = __hip_atomic_load(ctl + CW_ECNT, RLX_AGENT);
      float X = 0.1f + fminf(SELFCHECK == 1 ? eatt : esel, 0.8f); if (ecnt) X += 10.f; oscale = 1.0f + X; }
#endif
    PH(16, final_phase(F, poison, oscale););
}

extern "C" void kernel_launch(void* const* d_in, const int* in_sizes, int n_in, void* d_out, int out_size, void* d_ws, size_t ws_size, hipStream_t stream) {
    static int ready = 0;
    if (ready == 0) {
        if (n_in != 24 || in_sizes[0] != M * D || out_size != M * D || ws_size < WS_END) {
            fprintf(stderr, "kernel_launch: built for 24 inputs, x/out of %d floats, >= %zu bytes of workspace; got n_in %d in0 %d out %d ws %zu\n", M * D, (size_t)WS_END, n_in, n_in > 0 ? in_sizes[0] : -1, out_size, ws_size);
            ready = -1; return; }
        int dev = 0, cus = 0, per_cu = 0;
        if (hipGetDevice(&dev) != hipSuccess || hipDeviceGetAttribute(&cus, hipDeviceAttributeMultiprocessorCount, dev) != hipSuccess) { ready = -1; return; }
        if (hipFuncSetAttribute((const void*)fwd_kernel, hipFuncAttributeMaxDynamicSharedMemorySize, LDS_BYTES) != hipSuccess) { fprintf(stderr, "kernel_launch: hipFuncSetAttribute(%d) failed\n", LDS_BYTES); ready = -1; return; }
        if (hipOccupancyMaxActiveBlocksPerMultiprocessor(&per_cu, (const void*)fwd_kernel, NTHR, LDS_BYTES) != hipSuccess || per_cu < 1) fprintf(stderr, "kernel_launch: occupancy query says %d\n", per_cu);
        (void)hipGetLastError();
        if (cus < GRID) { fprintf(stderr, "kernel_launch: %d CUs < %d workgroups: not resident, nothing launched\n", cus, GRID); ready = -1; return; }
        ready = 1;
    }
    if (ready < 0) return;
    if (hipMemsetAsync((char*)d_ws + WS_CTL, 0, CTL_ZERO_BYTES, stream) != hipSuccess) return;
    Args a{};
    for (int i = 0; i < 24; ++i) a.in[i] = (const float*)d_in[i];
    a.out = (float*)d_out; a.ws = (unsigned char*)d_ws;
    hipLaunchKernelGGL(fwd_kernel, dim3(GRID), dim3(NTHR), LDS_BYTES, stream, a);
}
```

```cpp
#include <hip/hip_runtime.h>
#include <cstdio>
#include <cstdint>

#define GAS __attribute__((address_space(1)))
#define LAS __attribute__((address_space(3)))
typedef unsigned short bf16_t;
typedef short bf16x8 __attribute__((ext_vector_type(8)));
typedef short s16x4 __attribute__((ext_vector_type(4)));
typedef short s16x2 __attribute__((ext_vector_type(2)));
typedef float f32x2 __attribute__((ext_vector_type(2)));
typedef float f32x4 __attribute__((ext_vector_type(4)));
typedef float f32x16 __attribute__((ext_vector_type(16)));
typedef unsigned u32x2 __attribute__((ext_vector_type(2)));
typedef unsigned u32x4 __attribute__((ext_vector_type(4)));
typedef int i32x4 __attribute__((ext_vector_type(4)));
typedef int i32x8 __attribute__((ext_vector_type(8)));

constexpr int M = 32768, D = 2048, SEQ = 16384, NBATCH = 2;
constexpr int IN_COLS = 11344, NIN_TILES = 45, NIN_PAD = NIN_TILES * 256;
constexpr int NEXP = 32, NROWS_MAX = 139264  , NBLK_MAX = 544;
constexpr float LN_EPS = 1e-5f;
constexpr float DN_ALPHA = 1.189207115002721f;
constexpr float ATT_SCALE = 0.08838834764831845f;
constexpr int NWAVES = 8, NTHR = 512, GRID = 256;

constexpr size_t MiB = 1u << 20;
constexpr size_t WS_CTL = 0, CTL_ZERO_BYTES = 1 * MiB;
constexpr size_t WS_STATS = 1 * MiB;
constexpr size_t WS_WVCNT = WS_STATS + 256 * 1024;
constexpr size_t WS_EXPINFO = WS_WVCNT + 256 * 1024;
constexpr size_t WS_LOGITS = 2 * MiB;
constexpr size_t WS_TOPE = 6 * MiB;
constexpr size_t WS_TOPG = 6 * MiB + 512 * 1024;
constexpr size_t WS_SLOT = 7 * MiB;
constexpr size_t WS_ROWTOK = 7 * MiB + 512 * 1024;
constexpr size_t WS_ROWW = 8 * MiB + 256 * 1024;
constexpr size_t WS_WA = 10 * MiB, WS_WB = 14 * MiB, WS_WO = 18 * MiB, WS_WPG = 26 * MiB, WS_WPP = 34 * MiB;
constexpr size_t WS_PB = 35 * MiB;
constexpr size_t WS_WIN = 51 * MiB;
constexpr size_t WS_HB = 96 * MiB;
constexpr size_t WS_ATT = 96 * MiB;
constexpr size_t WS_PLE = 96 * MiB;
constexpr size_t WS_Q = 224 * MiB, WS_K = 288 * MiB, WS_V = 352 * MiB;
constexpr size_t WS_QI = 416 * MiB;
constexpr size_t WS_KI = 480 * MiB;
constexpr size_t WS_WI = 484 * MiB;
constexpr size_t WS_GB = 488 * MiB;
constexpr size_t WS_CU = 552 * MiB;
constexpr size_t WS_SGA = 616 * MiB, WS_SGB = 744 * MiB;
constexpr size_t WS_SC = 872 * MiB;
constexpr size_t WS_MASK = 1392 * MiB;
constexpr size_t WS_T2 = 1456 * MiB;
constexpr size_t WS_Y1 = 1024 * MiB;
constexpr size_t WS_H1B = 1584 * MiB;
constexpr size_t WS_H1L = 1712 * MiB;
constexpr size_t WS_H1F = 1840 * MiB;
constexpr size_t WS_HB8 = 1840 * MiB;
constexpr size_t WS_WIN8 = 1904 * MiB;
#ifndef WIN8_LO_V
#define WIN8_LO_V 12
#define WIN8_HI_V 12
#endif
constexpr int WIN8_LO = WIN8_LO_V, WIN8_HI = WIN8_HI_V;
__host__ __device__ constexpr bool win_tile_f8(int pn) { return pn < WIN8_LO || pn >= WIN8_HI; }
constexpr size_t WS_GB8 = 1928 * MiB;
constexpr size_t WS_WRH = 9 * MiB, WS_WRL = 9 * MiB + 128 * 1024;
constexpr size_t WS_W1 = 224 * MiB;
constexpr size_t WS_W2 = 768 * MiB;
constexpr size_t WS_ACT = 1024 * MiB;
constexpr size_t WS_OW = 224 * MiB;
constexpr size_t WS_END = 1968 * MiB;
constexpr size_t SC_BATCH = 134742016;

constexpr int CW_TMO = 0, CW_BAR = 4096;

constexpr int STAGE_BYTES_C = 131072;
constexpr int ROWTAB_OFF = 131072;
constexpr int UNITE_OFF = 148480;
constexpr int MISC_OFF = 148736;
constexpr int LDS_BYTES = 149504;

#define LDS_WAIT() asm volatile("s_waitcnt lgkmcnt(0)" ::: "memory")
#define VM_WAIT() asm volatile("s_waitcnt vmcnt(0)" ::: "memory")
#define RLX_AGENT __ATOMIC_RELAXED, __HIP_MEMORY_SCOPE_AGENT

__device__ __forceinline__ unsigned f2bf(float f) { unsigned u = __builtin_bit_cast(unsigned, f); return (u + 0x7fffu + ((u >> 16) & 1u)) >> 16; }
__device__ __forceinline__ unsigned cvt_pk_bf16(float lo, float hi) { unsigned r; asm volatile("v_cvt_pk_bf16_f32 %0, %1, %2" : "=v"(r) : "v"(lo), "v"(hi)); return r; }
__device__ __forceinline__ unsigned pk2(float lo, float hi) { unsigned r; asm("v_cvt_pk_bf16_f32 %0, %1, %2" : "=v"(r) : "v"(lo), "v"(hi)); return r; }
__device__ __forceinline__ float bf_lo(unsigned w) { return __builtin_bit_cast(float, w << 16); }
__device__ __forceinline__ float bf_hi(unsigned w) { return __builtin_bit_cast(float, w & 0xffff0000u); }
constexpr float QKV8_SCALE = 8.f, GB8_SCALE = 4.f;
__host__ __device__ constexpr int vt_pos(int u) { return 32 * ((u >> 2) & 1) + 16 * (u >> 5) + (u & 3) + 4 * ((u & 31) >> 3); }
constexpr float W8_SCALE = 512.f, ACT8_H1 = 8.f, ACT8_A = 4.f, OW8_SCALE = 32.f;
typedef float f32x2_t __attribute__((ext_vector_type(2)));
__device__ __forceinline__ float sat8(float x) { return __builtin_amdgcn_fmed3f(x, -448.f, 448.f); }
__device__ __forceinline__ unsigned pk4_fp8(float a, float b, float c, float d) { int r = __builtin_amdgcn_cvt_pk_fp8_f32(a, b, 0, false); r = __builtin_amdgcn_cvt_pk_fp8_f32(c, d, r, true); return (unsigned)r; }
__device__ __forceinline__ float fast_sigmoid(float x) { return __builtin_amdgcn_rcpf(1.0f + __builtin_amdgcn_exp2f(-1.4426950408889634f * x)); }
__device__ __forceinline__ float wave_sum(float v) {
#pragma unroll
    for (int o = 1; o < 64; o <<= 1) v += __shfl_xor(v, o);
    return v;
}

#define XB_TMO      128
#define XB_XCNT(j)  (256  + 64 * (j))
#define XB_XSUB(j)  (1280 + 64 * (j))
#define XB_XGEN(j)  (2304 + 64 * (j))
#define XB_TOP      3328
#define XB_TOPGEN   3392
#define XCD_BAR_WORDS 3456
#define XB_SPIN_CAP (1u << 18)

__device__ __forceinline__ unsigned xb_ld(unsigned* p)              { return __hip_atomic_load(p, __ATOMIC_RELAXED, __HIP_MEMORY_SCOPE_AGENT); }
__device__ __forceinline__ unsigned xb_add(unsigned* p, unsigned v) { return __hip_atomic_fetch_add(p, v, __ATOMIC_RELAXED, __HIP_MEMORY_SCOPE_AGENT); }
__device__ __forceinline__ unsigned xb_xcc_id() { return (unsigned)__builtin_amdgcn_s_getreg((3 << 11) | 20) & 0xFu; }
#define XB_SPIN(cond, bar) do { unsigned _sp = 0; while (cond) { __builtin_amdgcn_s_sleep(1); \
    if ((++_sp & 255u) == 0u) { if (xb_ld(&(bar)[XB_TMO])) break; if (_sp > XB_SPIN_CAP) { atomicAdd(&(bar)[XB_TMO], 1u); break; } } } } while (0)

struct XcdBarrier { unsigned* bar; unsigned x; volatile LAS unsigned* st; };

__device__ __forceinline__ XcdBarrier xcd_barrier_post(unsigned* bar, volatile LAS unsigned* st) {
    XcdBarrier b; b.bar = bar; b.x = xb_xcc_id(); b.st = st;
    if (threadIdx.x == 0) (void)xb_add(&bar[XB_XCNT(b.x)], 1u);
    return b;
}
__device__ __forceinline__ void xcd_barrier_complete(unsigned* bar, unsigned x, unsigned& nloc, unsigned& nx) {
    const unsigned G = gridDim.x * gridDim.y * gridDim.z;
    unsigned sum, cnt, mine, sp = 0u;
    for (;;) {
        sum = 0u; cnt = 0u; mine = 0u;
#pragma unroll
        for (unsigned j = 0; j < 16; ++j) { const unsigned c = xb_ld(&bar[XB_XCNT(j)]); sum += c; cnt += (c > 0u) ? 1u : 0u; mine = (j == x) ? c : mine; }
        if (sum == G) break;
        __builtin_amdgcn_s_sleep(1);
        if ((++sp & 255u) == 0u) { if (xb_ld(&bar[XB_TMO])) break; if (sp > XB_SPIN_CAP) { atomicAdd(&bar[XB_TMO], 1u); break; } }
    }
    nloc = mine > 0u ? mine : 1u; nx = cnt > 0u ? cnt : 1u;
}
__device__ __forceinline__ void xcd_barrier(const XcdBarrier& b) {
    asm volatile("s_waitcnt vmcnt(0)" ::: "memory");
    __syncthreads();
    if (threadIdx.x == 0) {
        unsigned* bar = b.bar;
        __builtin_amdgcn_s_waitcnt(0);
        unsigned nloc = b.st[0], nx = b.st[1];
        if (nloc == 0u) { xcd_barrier_complete(bar, b.x, nloc, nx); b.st[0] = nloc; b.st[1] = nx; }
        const unsigned old = xb_add(&bar[XB_XSUB(b.x)], 1u);
        const unsigned gen = old / nloc;
        if (old + 1u == (gen + 1u) * nloc) {
            __builtin_amdgcn_fence(__ATOMIC_RELEASE, "agent");
            asm volatile("s_waitcnt vmcnt(0)" ::: "memory");
            const unsigned og = xb_add(&bar[XB_TOP], 1u);
            const unsigned tg = og / nx;
            if (og + 1u == (tg + 1u) * nx) xb_add(&bar[XB_TOPGEN], 1u);
            else XB_SPIN(xb_ld(&bar[XB_TOPGEN]) == tg, bar);
            __builtin_amdgcn_fence(__ATOMIC_ACQUIRE, "agent");
            xb_add(&bar[XB_XGEN(b.x)], 1u);
            asm volatile("s_waitcnt vmcnt(0)" ::: "memory");
        } else {
            XB_SPIN(xb_ld(&bar[XB_XGEN(b.x)]) == gen, bar);
            __builtin_amdgcn_fence(__ATOMIC_ACQUIRE, "agent");
            asm volatile("s_waitcnt vmcnt(0)" ::: "memory");
        }
    }
    __syncthreads();
}
namespace pg8 {
constexpr int BM = 256, BK = 64, HALF = 128, HTB = HALF * BK * 2, STAGE_BYTES = 8 * HTB, NXCD = 8;
__host__ __device__ __forceinline__ int lds_byte(int r, int c) { const int st = (r >> 4) * 2 + (c >> 5), rr = r & 15, cc = c & 31, ob = rr * 64 + cc * 2; return st * 1024 + (ob ^ (((ob >> 9) & 1) << 5)); }
__host__ __device__ __forceinline__ void stage_rc(int b, int& R, int& C) { const int st = b / 1024, sb = b % 1024, swz = sb ^ (((sb >> 9) & 1) << 5); R = (st >> 1) * 16 + swz / 64; C = (st & 1) * 32 + (swz % 64) / 2; }
__host__ __device__ __forceinline__ int perm32(int rho) { const int n = rho >> 4, i = rho & 15; return 8 * (i >> 2) + 4 * n + (i & 3); }

struct Unit { int pm, pn; };
template <bool F8> struct Frag;
template <> struct Frag<false> { bf16x8 v[2]; };
template <> struct Frag<true> { i32x8 v; };
__device__ __forceinline__ void ldfrag(Frag<false>& f, const LAS unsigned char* p) { f.v[0] = *(const LAS bf16x8*)p; f.v[1] = *(const LAS bf16x8*)(p + 1024); }
__device__ __forceinline__ void ldfrag(Frag<true>& f, const LAS unsigned char* p) { const i32x4 lo = *(const LAS i32x4*)p, hi = *(const LAS i32x4*)(p + 1024); f.v = __builtin_shufflevector(lo, hi, 0, 1, 2, 3, 4, 5, 6, 7); }
__device__ __forceinline__ f32x4 mma(const Frag<false>& b, const Frag<false>& a, f32x4 c) { c = __builtin_amdgcn_mfma_f32_16x16x32_bf16(b.v[0], a.v[0], c, 0, 0, 0); return __builtin_amdgcn_mfma_f32_16x16x32_bf16(b.v[1], a.v[1], c, 0, 0, 0); }
__device__ __forceinline__ f32x4 mma(const Frag<true>& b, const Frag<true>& a, f32x4 c) { asm volatile("v_mfma_f32_16x16x128_f8f6f4 %0, %1, %2, %0" : "+v"(c) : "v"(b.v), "v"(a.v)); return c; }

struct StaticOrder {
    int nM, nN, nwg, G, c, WGM;
    __device__ __forceinline__ void init(int nM_, int nN_, int G_, int c_, int wgm = 4) { nM = nM_; nN = nN_; nwg = nM * nN; G = G_; c = c_; WGM = wgm; }
    __device__ __forceinline__ bool next(int i, Unit& u) const {
        const long L = (long)i * G + c; if (L >= nwg) return false;
        int wgid = (int)L;
#if !defined(ORDER_NOREMAP)
        { const int q = nwg / NXCD, r = nwg % NXCD, xcd = wgid % NXCD, off = wgid / NXCD; wgid = (xcd < r ? xcd * (q + 1) : r * (q + 1) + (xcd - r) * q) + off; }
#endif
        const int nig = WGM * nN, gid = wgid / nig, fm = gid * WGM, gsz = (nM - fm) < WGM ? (nM - fm) : WGM;
#if defined(ORDER_COLFAST)
        u.pm = fm + ((wgid % nig) / nN) % gsz; u.pn = (wgid % nig) % nN; return true;
#else
        u.pm = fm + ((wgid % nig) % gsz); u.pn = (wgid % nig) / gsz; return true;
#endif
    }
};

template <class Epi, class BSel, bool GATHER>
__device__ __forceinline__ void gemm_phase(LAS unsigned char* lds, const bf16_t* A, const int K, const StaticOrder& S, const BSel& bsel, const Epi& E, const LAS unsigned short* rowtab) {
    int tid = threadIdx.x; asm volatile("" : "+v"(tid));
    const int wid = __builtin_amdgcn_readfirstlane(tid >> 6), lane = tid & 63, wr = wid >> 2, wc = wid & 3, fr = lane & 15, fq = lane >> 4;
    const int nt = K / BK;
    unsigned voffA[2], voffB[2]; int RA[2], CA[2];
#pragma unroll
    for (int i = 0; i < 2; ++i) { int R, C; stage_rc(tid * 16 + i * 8192, R, C); const int Rb = Epi::PERM ? ((R & ~31) + perm32(R & 31)) : R;
        voffA[i] = (unsigned)(R * K + C) * 2u; voffB[i] = (unsigned)(Rb * K + C) * 2u; RA[i] = R; CA[i] = C; }
    const size_t kstep = (size_t)(BK * 2);
    const size_t hstep = (size_t)HALF * K * 2;
    const size_t hA = GATHER ? (size_t)0 : hstep;
    const size_t tstep = 2 * hstep;
    const unsigned ldsw = (unsigned)wid * 1024u;
    const int aoff = lds_byte(wr * 64 + fr, fq * 8), boff = lds_byte(wc * 32 + fr, fq * 8);
#define PG8_SA(b, h) (((b) * 2 + (h)) * HTB)
#define PG8_SB(b, h) ((4 + (b) * 2 + (h)) * HTB)
#define PG8_STAGE(bufoff, gbase, voff) do { _Pragma("unroll") for (int _i = 0; _i < 2; ++_i) \
        __builtin_amdgcn_global_load_lds((const unsigned*)((const char*)(gbase) + (voff)[_i]), (LAS unsigned*)(lds + (bufoff) + ldsw + _i * 8192), 16, 0, 0); } while (0)
#define PG8_LDA(dst, b, h) do { _Pragma("unroll") for (int m = 0; m < 4; ++m) ldfrag(dst[m], lds + PG8_SA(b, h) + aoff + m * 2048); } while (0)
#define PG8_LDB(dst, b, h) do { _Pragma("unroll") for (int n = 0; n < 2; ++n) ldfrag(dst[n], lds + PG8_SB(b, h) + boff + n * 2048); } while (0)
#define PG8_MMA(ai, bj, At, Bt) do { __builtin_amdgcn_s_setprio(1); _Pragma("unroll") for (int m = 0; m < 4; ++m) _Pragma("unroll") for (int n = 0; n < 2; ++n) \
        acc[ai][bj][m][n] = mma(Bt[n], At[m], acc[ai][bj][m][n]); __builtin_amdgcn_s_setprio(0); } while (0)
#define PG8_WAIT_V(n) asm volatile("s_waitcnt vmcnt(" #n ")" ::: "memory")
#define PG8_WAIT_L(n) asm volatile("s_waitcnt lgkmcnt(" #n ")" ::: "memory")
#define PG8_BAR __builtin_amdgcn_s_barrier()
#define PG8_SCHED __builtin_amdgcn_sched_barrier(0)
    Unit cur, nxt; int ui = 0;
    if (!S.next(0, cur)) return;
    f32x4 acc[2][2][4][2];
#pragma unroll
    for (int a = 0; a < 2; ++a)
#pragma unroll
        for (int b = 0; b < 2; ++b)
#pragma unroll
            for (int m = 0; m < 4; ++m)
#pragma unroll
                for (int n = 0; n < 2; ++n) acc[a][b][m][n] = (f32x4){0.f, 0.f, 0.f, 0.f};
    Frag<Epi::F8> At[4], B0[2], B1[2];
    unsigned vC0[2], vC1[2], vN0[2], vN1[2];
#pragma unroll
    for (int i = 0; i < 2; ++i) {
        if constexpr (GATHER) { vC0[i] = ((unsigned)rowtab[RA[i]] * (unsigned)K + (unsigned)CA[i]) * 2u; vC1[i] = ((unsigned)rowtab[HALF + RA[i]] * (unsigned)K + (unsigned)CA[i]) * 2u; }
        else { vC0[i] = voffA[i]; vC1[i] = voffA[i]; }
        vN0[i] = vC0[i]; vN1[i] = vC1[i];
    }
    const char* cA = GATHER ? (const char*)A : (const char*)A + (size_t)cur.pm * tstep; const char* cB = bsel(cur);
    PG8_STAGE(PG8_SB(0, 0), cB, voffB); PG8_STAGE(PG8_SB(0, 1), cB + hstep, voffB); PG8_STAGE(PG8_SA(0, 0), cA, vC0); PG8_STAGE(PG8_SA(0, 1), cA + hA, vC1);
    if (wr == 1) PG8_BAR;
    PG8_WAIT_V(2); PG8_BAR;
    PG8_STAGE(PG8_SB(1, 0), cB + kstep, voffB); PG8_STAGE(PG8_SA(1, 0), cA + kstep, vC0); PG8_STAGE(PG8_SB(1, 1), cB + hstep + kstep, voffB);
    PG8_WAIT_V(6); PG8_BAR;
    for (;;) {
        const bool has_next = S.next(ui + 1, nxt);
        const char* nA = GATHER ? (const char*)A : (has_next ? (const char*)A + (size_t)nxt.pm * tstep : cA); const char* nB = has_next ? bsel(nxt) : cB;
        for (int t = 0; t < nt; t += 2) {
            const bool last = (t == nt - 2);
            const char* a1 = cA + (size_t)(t + 1) * kstep;
            const char* a2 = last ? nA : cA + (size_t)(t + 2) * kstep; const char* b2 = last ? nB : cB + (size_t)(t + 2) * kstep;
            const char* a3 = a2 + kstep; const char* b3 = b2 + kstep;
            unsigned s0[2], s1[2];
            if constexpr (GATHER) {
                if (last && has_next) {
#pragma unroll
                    for (int i = 0; i < 2; ++i) { vN0[i] = ((unsigned)rowtab[(ui + 1) * 256 + RA[i]] * (unsigned)K + (unsigned)CA[i]) * 2u; vN1[i] = ((unsigned)rowtab[(ui + 1) * 256 + HALF + RA[i]] * (unsigned)K + (unsigned)CA[i]) * 2u; }
                }
#pragma unroll
                for (int i = 0; i < 2; ++i) { s0[i] = last ? vN0[i] : vC0[i]; s1[i] = last ? vN1[i] : vC1[i]; }
            } else {
#pragma unroll
                for (int i = 0; i < 2; ++i) { s0[i] = voffA[i]; s1[i] = voffA[i]; }
            }
            PG8_LDB(B0, 0, 0); PG8_LDB(B1, 0, 1); PG8_SCHED; PG8_LDA(At, 0, 0); PG8_STAGE(PG8_SA(1, 1), a1 + hA, vC1);
            PG8_WAIT_V(8); PG8_WAIT_L(0); PG8_BAR; PG8_MMA(0, 0, At, B0); PG8_MMA(0, 1, At, B1); PG8_BAR; PG8_SCHED;
            PG8_LDA(At, 0, 1); PG8_STAGE(PG8_SB(0, 0), b2, voffB); PG8_STAGE(PG8_SB(0, 1), b2 + hstep, voffB); PG8_STAGE(PG8_SA(0, 0), a2, s0);
            PG8_WAIT_V(8); PG8_WAIT_L(0); PG8_BAR; PG8_MMA(1, 0, At, B0); PG8_MMA(1, 1, At, B1); PG8_BAR; PG8_SCHED;
            PG8_LDB(B0, 1, 0); PG8_LDB(B1, 1, 1); PG8_SCHED; PG8_LDA(At, 1, 0); PG8_STAGE(PG8_SA(0, 1), a2 + hA, s1);
            PG8_WAIT_V(8); PG8_WAIT_L(0); PG8_BAR; PG8_MMA(0, 0, At, B0); PG8_MMA(0, 1, At, B1); PG8_BAR; PG8_SCHED;
            PG8_LDA(At, 1, 1); PG8_STAGE(PG8_SB(1, 0), b3, voffB); PG8_STAGE(PG8_SB(1, 1), b3 + hstep, voffB); PG8_STAGE(PG8_SA(1, 0), a3, s0);
            PG8_WAIT_V(8); PG8_WAIT_L(0); PG8_BAR; PG8_MMA(1, 0, At, B0); PG8_MMA(1, 1, At, B1); PG8_BAR; PG8_SCHED;
        }
        if constexpr (Epi::F8) asm volatile("s_nop 15\n\ts_nop 15\n\ts_nop 15" ::: "memory");
        if (wr == 0) PG8_BAR;
        E(acc, cur, wr, wc, fr, fq);
        if (!has_next) break;
#pragma unroll
        for (int a = 0; a < 2; ++a)
#pragma unroll
            for (int b = 0; b < 2; ++b)
#pragma unroll
                for (int m = 0; m < 4; ++m)
#pragma unroll
                    for (int n = 0; n < 2; ++n) acc[a][b][m][n] = (f32x4){0.f, 0.f, 0.f, 0.f};
        cur = nxt; cA = nA; cB = nB; ++ui;
#pragma unroll
        for (int i = 0; i < 2; ++i) { vC0[i] = vN0[i]; vC1[i] = vN1[i]; }
        if (wr == 1) PG8_BAR;
    }
    PG8_WAIT_V(0);
    PG8_BAR;
#undef PG8_SA
#undef PG8_SB
#undef PG8_STAGE
#undef PG8_LDA
#undef PG8_LDB
#undef PG8_MMA
#undef PG8_WAIT_V
#undef PG8_WAIT_L
#undef PG8_BAR
#undef PG8_SCHED
}
}
struct BPlain { const char* Bt; size_t tstep; __device__ __forceinline__ const char* operator()(const pg8::Unit& u) const { return Bt + (size_t)u.pn * tstep; } };
template <bool F8_> struct BWin {
    const char* Bt; size_t tstep;
    static __device__ __forceinline__ int tile(int p) { return F8_ ? (p < WIN8_LO ? p : p + (WIN8_HI - WIN8_LO)) : p + WIN8_LO; }
    __device__ __forceinline__ const char* operator()(const pg8::Unit& u) const { return Bt + (size_t)tile(u.pn) * tstep; } };
struct BExpert { const char* Bt; size_t estride, tstep; const int* blke; __device__ __forceinline__ const char* operator()(const pg8::Unit& u) const { return Bt + (size_t)blke[u.pm] * estride + (size_t)u.pn * tstep; } };

__device__ __forceinline__ u32x4 pack8bf(const f32x4 v0, const f32x4 v1) { u32x4 w; w.x = cvt_pk_bf16(v0[0], v0[1]); w.y = cvt_pk_bf16(v0[2], v0[3]); w.z = cvt_pk_bf16(v1[0], v1[1]); w.w = cvt_pk_bf16(v1[2], v1[3]); return w; }
__device__ __forceinline__ void unpack8bf(const u32x4 w, f32x4& v0, f32x4& v1) { v0 = (f32x4){bf_lo(w.x), bf_hi(w.x), bf_lo(w.y), bf_hi(w.y)}; v1 = (f32x4){bf_lo(w.z), bf_hi(w.z), bf_lo(w.w), bf_hi(w.w)}; }
__device__ __forceinline__ f32x4 sig4(const f32x4 v) { return (f32x4){fast_sigmoid(v[0]), fast_sigmoid(v[1]), fast_sigmoid(v[2]), fast_sigmoid(v[3])}; }

template <bool F8_> struct EpiIn {
    static constexpr bool PERM = true, F8 = F8_;
    static constexpr float SC = F8_ ? 1.0f / (ACT8_H1 * W8_SCALE) : 1.0f;
    bf16_t *Q, *Kt, *V, *QI, *KI, *GB, *CU, *SGA, *SGB; float* WI;
    __device__ __forceinline__ void operator()(const f32x4 (&acc)[2][2][4][2], const pg8::Unit& u, int wr, int wc, int fr, int fq) const {
        const int row0 = u.pm * 256 + wr * 64 + fr, pn = BWin<F8_>::tile(u.pn), c8 = wc * 32 + 8 * fq;
        if (pn == 16) {
#pragma unroll
            for (int ai = 0; ai < 2; ++ai)
#pragma unroll
                for (int m = 0; m < 4; ++m) { const size_t row = (size_t)(row0 + ai * 128 + m * 16);
                    if (wc < 2) { const f32x4 k0 = acc[ai][0][m][0] * (SC * QKV8_SCALE), k1 = acc[ai][0][m][1] * (SC * QKV8_SCALE);
                        *(u32x2*)((unsigned char*)KI + row * 64 + c8) = (u32x2){pk4_fp8(sat8(k0[0]), sat8(k0[1]), sat8(k0[2]), sat8(k0[3])), pk4_fp8(sat8(k1[0]), sat8(k1[1]), sat8(k1[2]), sat8(k1[3]))}; }
                    else if (wc == 2 && fq < 2) { *(f32x4*)(WI + row * 16 + 8 * fq) = acc[ai][0][m][0] * SC; *(f32x4*)(WI + row * 16 + 8 * fq + 4) = acc[ai][0][m][1] * SC; } }
            return;
        }
        if (pn >= 21 && pn < 29) {
#pragma unroll
            for (int ai = 0; ai < 2; ++ai)
#pragma unroll
                for (int m = 0; m < 4; ++m) { const size_t row = (size_t)(row0 + ai * 128 + m * 16);
                    *(u32x4*)(CU + row * 1024 + (pn - 21) * 128 + c8) = pack8bf(acc[ai][0][m][0] * acc[ai][1][m][0] * (SC * SC), acc[ai][0][m][1] * acc[ai][1][m][1] * (SC * SC)); }
            return;
        }
        if (F8_ && pn < 12) {
            const int t = pn >> 2;
#pragma unroll
            for (int ai = 0; ai < 2; ++ai)
#pragma unroll
                for (int m = 0; m < 4; ++m) { const int row = row0 + ai * 128 + m * 16;
#pragma unroll
                    for (int bj = 0; bj < 2; ++bj) { const int head = 2 * (pn & 3) + bj; const f32x4 v0 = acc[ai][bj][m][0] * (SC * QKV8_SCALE), v1 = acc[ai][bj][m][1] * (SC * QKV8_SCALE);
                        const unsigned w0 = pk4_fp8(sat8(v0[0]), sat8(v0[1]), sat8(v0[2]), sat8(v0[3])), w1 = pk4_fp8(sat8(v1[0]), sat8(v1[1]), sat8(v1[2]), sat8(v1[3]));
                        if (t < 2) *(u32x2*)((unsigned char*)Q + (size_t)t * (WS_K - WS_Q) + ((size_t)head * M + row) * 128 + c8) = (u32x2){w0, w1};
                        else { unsigned char* vb = (unsigned char*)V + ((size_t)head * M + (size_t)(row & ~63)) * 128 + (size_t)c8 * 64 + vt_pos(row & 63);
#pragma unroll
                            for (int e_ = 0; e_ < 4; ++e_) { vb[e_ * 64] = (unsigned char)(w0 >> (8 * e_)); vb[(4 + e_) * 64] = (unsigned char)(w1 >> (8 * e_)); } } } }
            return;
        }
        if (pn >= 12 && pn < 16) {
#pragma unroll
            for (int ai = 0; ai < 2; ++ai)
#pragma unroll
                for (int m = 0; m < 4; ++m) { const size_t row = (size_t)(row0 + ai * 128 + m * 16);
#pragma unroll
                    for (int bj = 0; bj < 2; ++bj) { const f32x4 v0 = acc[ai][bj][m][0] * (SC * QKV8_SCALE), v1 = acc[ai][bj][m][1] * (SC * QKV8_SCALE);
                        *(u32x2*)((unsigned char*)QI + row * 1024 + (pn - 12) * 256 + bj * 128 + c8) = (u32x2){pk4_fp8(sat8(v0[0]), sat8(v0[1]), sat8(v0[2]), sat8(v0[3])), pk4_fp8(sat8(v1[0]), sat8(v1[1]), sat8(v1[2]), sat8(v1[3]))}; } }
            return;
        }
        bf16_t* dst; int ld; size_t bjs; bool sig = false;
        if (pn < 12) { const int t = pn >> 2; dst = Q + (size_t)t * ((WS_K - WS_Q) / 2) + (size_t)(2 * (pn & 3)) * M * 128; ld = 128; bjs = (size_t)M * 128; }
        else if (pn < 16) { dst = QI + (pn - 12) * 256; ld = 1024; bjs = 128; }
        else if (pn < 21) { dst = GB + (pn - 17) * 256; ld = 1024; bjs = 128; }
        else if (pn < 37) { dst = SGA + (pn - 29) * 256; ld = 2048; bjs = 128; sig = true; }
        else { dst = SGB + (pn - 37) * 256; ld = 2048; bjs = 128; sig = true; }
#pragma unroll
        for (int ai = 0; ai < 2; ++ai)
#pragma unroll
            for (int m = 0; m < 4; ++m) { bf16_t* rp = dst + (size_t)(row0 + ai * 128 + m * 16) * ld + c8;
#pragma unroll
                for (int bj = 0; bj < 2; ++bj) { f32x4 v0 = acc[ai][bj][m][0] * SC, v1 = acc[ai][bj][m][1] * SC;
                    if (sig) { v0 = sig4(v0); v1 = sig4(v1); }
                    *(u32x4*)(rp + bj * bjs) = pack8bf(v0, v1); } }
    }
};
template <bool HAS_ADD, int ASCALE = 0> struct EpiGate {
    static constexpr bool PERM = true, F8 = ASCALE > 0;
    static constexpr float SC = ASCALE > 0 ? 1.0f / ((float)ASCALE * W8_SCALE) : 1.0f;
    const bf16_t* G; const bf16_t* ADD; bf16_t* O;
    __device__ __forceinline__ void operator()(const f32x4 (&acc)[2][2][4][2], const pg8::Unit& u, int wr, int wc, int fr, int fq) const {
        const int row0 = u.pm * 256 + wr * 64 + fr, col0 = u.pn * 256 + wc * 32 + 8 * fq;
#pragma unroll
        for (int ai = 0; ai < 2; ++ai)
#pragma unroll
            for (int m = 0; m < 4; ++m) { const size_t off = (size_t)(row0 + ai * 128 + m * 16) * 2048 + col0;
#pragma unroll
                for (int bj = 0; bj < 2; ++bj) { f32x4 g0, g1; unpack8bf(*(const u32x4*)(G + off + bj * 128), g0, g1);
                    f32x4 v0 = acc[ai][bj][m][0] * g0 * SC, v1 = acc[ai][bj][m][1] * g1 * SC;
                    if (HAS_ADD) { f32x4 a0, a1; unpack8bf(*(const u32x4*)(ADD + off + bj * 128), a0, a1); v0 += a0; v1 += a1; }
                    *(u32x4*)(O + off + bj * 128) = pack8bf(v0, v1); } }
    }
};
struct EpiY1 {
    static constexpr bool PERM = false, F8 = false;
    const float* x; const float* mu; const float* rstd; const float* g; const float* b; float* Y;
    __device__ __forceinline__ void operator()(const f32x4 (&acc)[2][2][4][2], const pg8::Unit& u, int wr, int wc, int fr, int fq) const {
        const int row0 = u.pm * 256 + wr * 64 + fr, col0 = u.pn * 256 + wc * 32 + 4 * fq;
        f32x4 gv[2][2], bv[2][2];
#pragma unroll
        for (int bj = 0; bj < 2; ++bj)
#pragma unroll
            for (int n = 0; n < 2; ++n) { gv[bj][n] = *(const f32x4*)(g + col0 + bj * 128 + n * 16) * DN_ALPHA; bv[bj][n] = *(const f32x4*)(b + col0 + bj * 128 + n * 16) * DN_ALPHA; }
#pragma unroll
        for (int ai = 0; ai < 2; ++ai)
#pragma unroll
            for (int m = 0; m < 4; ++m) { const int row = row0 + ai * 128 + m * 16; const float mr = mu[row], rs = rstd[row]; const size_t off = (size_t)row * 2048 + col0;
#pragma unroll
                for (int bj = 0; bj < 2; ++bj)
#pragma unroll
                    for (int n = 0; n < 2; ++n) { const f32x4 xv = *(const f32x4*)(x + off + bj * 128 + n * 16);
                        *(f32x4*)(Y + off + bj * 128 + n * 16) = ((xv - mr) * rs) * gv[bj][n] + bv[bj][n] + acc[ai][bj][m][n]; } }
    }
};
struct EpiPlain {
    static constexpr bool PERM = true, F8 = false;
    bf16_t* O;
    __device__ __forceinline__ void operator()(const f32x4 (&acc)[2][2][4][2], const pg8::Unit& u, int wr, int wc, int fr, int fq) const {
        const int row0 = u.pm * 256 + wr * 64 + fr, col0 = u.pn * 256 + wc * 32 + 8 * fq;
#pragma unroll
        for (int ai = 0; ai < 2; ++ai)
#pragma unroll
            for (int m = 0; m < 4; ++m) { const size_t off = (size_t)(row0 + ai * 128 + m * 16) * 2048 + col0;
#pragma unroll
                for (int bj = 0; bj < 2; ++bj) *(u32x4*)(O + off + bj * 128) = pack8bf(acc[ai][bj][m][0], acc[ai][bj][m][1]); }
    }
};
struct EpiPle {
    static constexpr bool PERM = true, F8 = true;
    bf16_t* PP;
    __device__ __forceinline__ void operator()(const f32x4 (&acc)[2][2][4][2], const pg8::Unit& u, int wr, int wc, int fr, int fq) const {
        const int row0 = u.pm * 256 + wr * 64 + fr, col0 = u.pn * 256 + wc * 32 + 8 * fq;
#pragma unroll
        for (int ai = 0; ai < 2; ++ai)
#pragma unroll
            for (int m = 0; m < 4; ++m) { const size_t off = (size_t)(row0 + ai * 128 + m * 16) * 2048 + col0;
#pragma unroll
                for (int bj = 0; bj < 2; ++bj) { f32x4 p0, p1; unpack8bf(*(const u32x4*)(PP + off + bj * 128), p0, p1);
                    *(u32x4*)(PP + off + bj * 128) = pack8bf(sig4(acc[ai][bj][m][0] * (1.0f / (ACT8_H1 * W8_SCALE))) * p0, sig4(acc[ai][bj][m][1] * (1.0f / (ACT8_H1 * W8_SCALE))) * p1); } }
    }
};
struct EpiAct {
    static constexpr bool PERM = true, F8 = true;
    const float* bg; const float* bu; const int* blke; unsigned char* ACT;
    __device__ __forceinline__ void operator()(const f32x4 (&acc)[2][2][4][2], const pg8::Unit& u, int wr, int wc, int fr, int fq) const {
        const int row0 = u.pm * 256 + wr * 64 + fr, col0 = u.pn * 128 + wc * 32 + 8 * fq, e = blke[u.pm];
        const f32x4 bg0 = *(const f32x4*)(bg + e * 2048 + col0), bg1 = *(const f32x4*)(bg + e * 2048 + col0 + 4), bu0 = *(const f32x4*)(bu + e * 2048 + col0), bu1 = *(const f32x4*)(bu + e * 2048 + col0 + 4);
#pragma unroll
        for (int ai = 0; ai < 2; ++ai)
#pragma unroll
            for (int m = 0; m < 4; ++m) { const size_t off = (size_t)(row0 + ai * 128 + m * 16) * 2048 + col0;
                f32x2 o[2][2];
#pragma unroll
                for (int n = 0; n < 2; ++n)
#pragma unroll
                    for (int h = 0; h < 2; ++h) { constexpr float SCg = 1.0f / (ACT8_H1 * W8_SCALE), KE = -1.702f * 1.4426950408889634f;
                        const f32x4 ag4 = acc[ai][0][m][n], au4 = acc[ai][1][m][n], bgv = n ? bg1 : bg0, buv = n ? bu1 : bu0;
                        const f32x2 gg = __builtin_elementwise_fma((f32x2){ag4[2 * h], ag4[2 * h + 1]}, (f32x2){SCg, SCg}, (f32x2){bgv[2 * h], bgv[2 * h + 1]});
                        const f32x2 uu = __builtin_elementwise_fma((f32x2){au4[2 * h], au4[2 * h + 1]}, (f32x2){SCg, SCg}, (f32x2){buv[2 * h], buv[2 * h + 1]});
                        const f32x2 gc = {fminf(gg[0], 7.0f), fminf(gg[1], 7.0f)}, uc = {__builtin_amdgcn_fmed3f(uu[0], -7.0f, 7.0f), __builtin_amdgcn_fmed3f(uu[1], -7.0f, 7.0f)};
                        const f32x2 x = gc * (f32x2){KE, KE};
                        const f32x2 d = (f32x2){__builtin_amdgcn_exp2f(x[0]), __builtin_amdgcn_exp2f(x[1])} + (f32x2){1.0f, 1.0f};
                        const f32x2 sg = {__builtin_amdgcn_rcpf(d[0]), __builtin_amdgcn_rcpf(d[1])};
                        o[n][h] = __builtin_elementwise_fma(uc, (f32x2){ACT8_A, ACT8_A}, (f32x2){ACT8_A, ACT8_A}) * (gc * sg); }
                *(u32x2*)(ACT + off) = (u32x2){pk4_fp8(o[0][0][0], o[0][0][1], o[0][1][0], o[0][1][1]), pk4_fp8(o[1][0][0], o[1][0][1], o[1][1][0], o[1][1][1])}; }
    }
};
struct EpiDown {
    static constexpr bool PERM = true, F8 = true;
    const float* bd; const int* blke; const float* roww; unsigned char* OW;
    __device__ __forceinline__ void operator()(const f32x4 (&acc)[2][2][4][2], const pg8::Unit& u, int wr, int wc, int fr, int fq) const {
        const int row0 = u.pm * 256 + wr * 64 + fr, col0 = u.pn * 256 + wc * 32 + 8 * fq, e = blke[u.pm];
        f32x4 bv[2][2];
#pragma unroll
        for (int bj = 0; bj < 2; ++bj)
#pragma unroll
            for (int n = 0; n < 2; ++n) bv[bj][n] = *(const f32x4*)(bd + e * 2048 + col0 + bj * 128 + 4 * n);
#pragma unroll
        for (int ai = 0; ai < 2; ++ai)
#pragma unroll
            for (int m = 0; m < 4; ++m) { const int row = row0 + ai * 128 + m * 16; const float w = roww[row]; const size_t off = (size_t)row * 2048 + col0;
#pragma unroll
                for (int bj = 0; bj < 2; ++bj) { const f32x4 x0 = (acc[ai][bj][m][0] * (1.0f / (ACT8_A * W8_SCALE)) + bv[bj][0]) * (w * OW8_SCALE), x1 = (acc[ai][bj][m][1] * (1.0f / (ACT8_A * W8_SCALE)) + bv[bj][1]) * (w * OW8_SCALE);
                    *(u32x2*)(OW + off + bj * 128) = (u32x2){pk4_fp8(sat8(x0[0]), sat8(x0[1]), sat8(x0[2]), sat8(x0[3])), pk4_fp8(sat8(x1[0]), sat8(x1[1]), sat8(x1[2]), sat8(x1[3]))}; } }
    }
};
struct Args { const float* in[24]; float* out; unsigned char* ws; };
struct Frame {
    LAS unsigned char* lds;
    int tid, lane, wave, wg, G;
    const Args* a;
    float* out; unsigned char* ws;
    __device__ __forceinline__ const float* inp(int i) const { asm volatile("" : "+s"(i)); return a->in[i]; }
};
enum { I_X = 0, I_P, I_LNG, I_LNB, I_RELB, I_WIN, I_CONVW, I_WATT, I_WCONV, I_WO, I_LN1G, I_LN1B, I_WR, I_BR, I_WG, I_BG, I_WU, I_BU, I_WD, I_BD, I_WPG, I_WPP, I_LN2G, I_LN2B };

__device__ __forceinline__ int win_dst_row(int n) {
    if (n < 4176) return n;
    if (n < 5200) return 4352 + (n - 4176);
    if (n < 6224) { const int c = n - 5200; return 5376 + (c >> 7) * 256 + (c & 127); }
    if (n < 7248) { const int c = n - 6224; return 5376 + (c >> 7) * 256 + 128 + (c & 127); }
    return 7424 + (n - 7248);
}
struct TrItem { const float* W; bf16_t* WT; int K, N, k0, n0, map; };
constexpr int TR_LDS_STRIDE = 64 * 65 * 4;
__device__ __forceinline__ void tr_load(const TrItem& t, float (&r)[64], int lane) {
    const int nl = t.n0 + lane;
#pragma unroll
    for (int i = 0; i < 64; ++i) r[i] = (nl < t.N) ? __builtin_nontemporal_load(t.W + (size_t)(t.k0 + i) * t.N + nl) : 0.f;
}
template <int F8> __device__ __forceinline__ void tr_store(const TrItem& t, const float (&r)[64], LAS float* scr, int lane, unsigned char* ws) {
#pragma unroll
    for (int i = 0; i < 64; ++i) scr[i * 65 + lane] = r[i];
    LDS_WAIT(); asm volatile("" ::: "memory");
    const int c = lane & 7;
#pragma unroll
    for (int j = 0; j < 8; ++j) { const int nn = (lane >> 3) + 8 * j, n = t.n0 + nn; const LAS float* s = scr + (8 * c) * 65 + nn;
        u32x4 o; o.x = pk2(s[0 * 65], s[1 * 65]); o.y = pk2(s[2 * 65], s[3 * 65]); o.z = pk2(s[4 * 65], s[5 * 65]); o.w = pk2(s[6 * 65], s[7 * 65]);
        int dr = n;
        if (t.map == 1) dr = win_dst_row(n);
        if (t.map == 2) dr = (n >> 7) * 256 + (n & 127);
        if (t.map == 3) dr = (n >> 7) * 256 + 128 + (n & 127);
        if constexpr (F8 != 0) {
            const u32x2 o8 = {pk4_fp8(sat8(s[0 * 65] * W8_SCALE), sat8(s[1 * 65] * W8_SCALE), sat8(s[2 * 65] * W8_SCALE), sat8(s[3 * 65] * W8_SCALE)), pk4_fp8(sat8(s[4 * 65] * W8_SCALE), sat8(s[5 * 65] * W8_SCALE), sat8(s[6 * 65] * W8_SCALE), sat8(s[7 * 65] * W8_SCALE))};
            if constexpr (F8 == 1) { if (n < t.N) __builtin_nontemporal_store(o8, (u32x2*)((unsigned char*)t.WT + (size_t)dr * t.K + t.k0 + 8 * c)); }
            else { const bool f8row = win_tile_f8(dr >> 8);
                if (n < t.N && f8row) __builtin_nontemporal_store(o8, (u32x2*)(ws + WS_WIN8 + (size_t)dr * t.K + t.k0 + 8 * c));
                if (n < t.N && !f8row) __builtin_nontemporal_store(o, (u32x4*)(t.WT + (size_t)dr * t.K + t.k0 + 8 * c)); }
        } else if (n < t.N) __builtin_nontemporal_store(o, (u32x4*)(t.WT + (size_t)dr * t.K + t.k0 + 8 * c)); }
    LDS_WAIT(); asm volatile("" ::: "memory");
}
__device__ __forceinline__ TrItem tr_make(const float* W, int K, int N, bf16_t* WT, int item, int map) {
    const int nblk = (N + 63) / 64, kb = item / nblk, nb = item % nblk; TrItem t; t.W = W; t.WT = WT; t.K = K; t.N = N; t.k0 = 64 * kb; t.n0 = 64 * nb; t.map = map; return t;
}
__device__ __forceinline__ TrItem win_item(const Frame& F, int it) { return tr_make(F.inp(I_WIN), 2048, IN_COLS, (bf16_t*)(F.ws + WS_WIN), it, 1); }
__device__ __forceinline__ TrItem p0_item(const Frame& F, int it) {
    constexpr int I_O = 32 * 32;
    int r = it;
    if (r < I_O) return tr_make(F.inp(I_WO), 2048, 2048, (bf16_t*)(F.ws + WS_WO), r, 0); r -= I_O;
    return tr_make(F.inp(I_WPP), 256, 2048, (bf16_t*)(F.ws + WS_WPP), r, 0);
}
__device__ __forceinline__ TrItem moe_item_w1(const Frame& F, int it) {
    constexpr int PER = 32 * 32;
    const int e = it / (2 * PER), r = it % (2 * PER), which = r / PER, item = r % PER; const size_t wo = (size_t)e * 2048 * 2048;
    if (which == 0) return tr_make(F.inp(I_WG) + wo, 2048, 2048, (bf16_t*)(F.ws + WS_W1 + (size_t)e * 4096 * 2048), item, 2);
    return tr_make(F.inp(I_WU) + wo, 2048, 2048, (bf16_t*)(F.ws + WS_W1 + (size_t)e * 4096 * 2048), item, 3);
}
__device__ __forceinline__ TrItem moe_item_w2(const Frame& F, int it) {
    constexpr int PER = 32 * 32;
    const int e = it / PER, item = it % PER; const size_t wo = (size_t)e * 2048 * 2048;
    return tr_make(F.inp(I_WD) + wo, 2048, 2048, (bf16_t*)(F.ws + WS_W2 + wo), item, 0);
}
__device__ __forceinline__ TrItem wa_item(const Frame& F, int it) { return tr_make(F.inp(I_WATT), 1024, 2048, (bf16_t*)(F.ws + WS_WA), it, 0); }
__device__ __forceinline__ TrItem wb_item(const Frame& F, int it) { return tr_make(F.inp(I_WCONV), 1024, 2048, (bf16_t*)(F.ws + WS_WB), it, 0); }
__device__ __forceinline__ TrItem wpg_item(const Frame& F, int it) { return tr_make(F.inp(I_WPG), 2048, 2048, (bf16_t*)(F.ws + WS_WPG), it, 0); }
#define TR_LOOP(MAKE, NITEMS, F8) do { const int gw_ = F.wg * NWAVES + F.wave, NGW_ = F.G * NWAVES; LAS float* scr_ = (LAS float*)(F.lds + F.wave * TR_LDS_STRIDE); \
    int it_ = gw_; if (it_ < (NITEMS)) { TrItem cur_ = MAKE(F, it_); float ra_[64]; tr_load(cur_, ra_, F.lane); \
        for (;;) { const int nx_ = it_ + NGW_; const bool more_ = nx_ < (NITEMS); TrItem nxt_ = cur_; float rb_[64]; if (more_) { nxt_ = MAKE(F, nx_); tr_load(nxt_, rb_, F.lane); } \
            tr_store<F8>(cur_, ra_, scr_, F.lane, F.ws); if (!more_) break; \
            _Pragma("unroll") for (int q_ = 0; q_ < 64; ++q_) ra_[q_] = rb_[q_]; cur_ = nxt_; it_ = nx_; } } } while (0)
__device__ __forceinline__ void p0_prologue(const Frame& F) {
    const int gw = F.wg * NWAVES + F.wave, NGW = F.G * NWAVES;
    bf16_t* WinT = (bf16_t*)(F.ws + WS_WIN);
    constexpr int NITEMS = 32 * 32 + 4 * 32;
    TR_LOOP(win_item, 32 * 178, 2);
    TR_LOOP(p0_item, NITEMS, 0);
    TR_LOOP(wpg_item, 32 * 32, 1);
    TR_LOOP(wb_item, 16 * 32, 1);
    TR_LOOP(wa_item, 16 * 32, 1);
    { const float* wr = F.inp(I_WR); bf16_t* WRH = (bf16_t*)(F.ws + WS_WRH); bf16_t* WRL = (bf16_t*)(F.ws + WS_WRL);
      for (int i = gw * 64 + F.lane; i < 2048 * 32; i += NGW * 64) { const int c = i >> 5, e = i & 31; const float w = wr[i]; const unsigned h = f2bf(w); WRH[(size_t)e * 2048 + c] = (bf16_t)h; WRL[(size_t)e * 2048 + c] = (bf16_t)f2bf(w - bf_lo(h)); } }
    for (int i = gw * 64 + F.lane; i < 176 * 2048 / 8; i += NGW * 64) *(u32x4*)(WinT + (size_t)4176 * 2048 + (size_t)i * 8) = (u32x4){0u, 0u, 0u, 0u};
    { const float* p = F.inp(I_P); bf16_t* PB = (bf16_t*)(F.ws + WS_PB);
      for (int i = gw * 64 + F.lane; i < M * 256 / 8; i += NGW * 64) { const f32x4 a = *(const f32x4*)(p + (size_t)i * 8), b = *(const f32x4*)(p + (size_t)i * 8 + 4);
          *(u32x4*)(PB + (size_t)i * 8) = (u32x4){pk2(a[0], a[1]), pk2(a[2], a[3]), pk2(b[0], b[1]), pk2(b[2], b[3])}; } }
    { const float* x = F.inp(I_X); const float* g = F.inp(I_LNG); const float* bb = F.inp(I_LNB); bf16_t* HB = (bf16_t*)(F.ws + WS_HB);
      float* mu = (float*)(F.ws + WS_STATS); float* rstd = mu + M;
      f32x4 gv[8], bv[8];
#pragma unroll
      for (int j = 0; j < 8; ++j) { gv[j] = *(const f32x4*)(g + 4 * F.lane + 256 * j); bv[j] = *(const f32x4*)(bb + 4 * F.lane + 256 * j); }
      for (int m = gw; m < M; m += NGW) {
          const float* xr = x + (size_t)m * D + 4 * F.lane; f32x4 v[8]; float s = 0.f;
#pragma unroll
          for (int j = 0; j < 8; ++j) { v[j] = __builtin_nontemporal_load((const f32x4*)(xr + 256 * j)); s += (v[j][0] + v[j][1]) + (v[j][2] + v[j][3]); }
          const float mean = wave_sum(s) * (1.f / D); float s2 = 0.f;
#pragma unroll
          for (int j = 0; j < 8; ++j) { v[j] = v[j] - mean; s2 += (v[j][0] * v[j][0] + v[j][1] * v[j][1]) + (v[j][2] * v[j][2] + v[j][3] * v[j][3]); }
          const float rs = 1.f / sqrtf(wave_sum(s2) * (1.f / D) + LN_EPS);
          if (F.lane == 0) { mu[m] = mean; rstd[m] = rs; }
          bf16_t* orow = HB + (size_t)m * D + 4 * F.lane; unsigned char* orow8 = F.ws + WS_HB8 + (size_t)m * D + 4 * F.lane;
#pragma unroll
          for (int j = 0; j < 8; ++j) { const f32x4 y = v[j] * rs * gv[j] + bv[j];
              *(unsigned*)(orow8 + 256 * j) = pk4_fp8(sat8(y[0] * ACT8_H1), sat8(y[1] * ACT8_H1), sat8(y[2] * ACT8_H1), sat8(y[3] * ACT8_H1)); }
      } }
}
__device__ __forceinline__ void moe_w1_convert(const Frame& F) { TR_LOOP(moe_item_w1, NEXP * 2 * 32 * 32, 1); }
__device__ __forceinline__ void moe_w2_convert(const Frame& F) { TR_LOOP(moe_item_w2, NEXP * 32 * 32, 1); }
__device__ __forceinline__ void conv_phase(const Frame& F) {
    bf16_t* GB = (bf16_t*)(F.ws + WS_GB); const bf16_t* CU = (const bf16_t*)(F.ws + WS_CU); const float* cw = F.inp(I_CONVW);
    const int c8 = (F.tid & 127) * 8;
    f32x4 w0a = *(const f32x4*)(cw + c8), w0b = *(const f32x4*)(cw + c8 + 4), w1a = *(const f32x4*)(cw + 1024 + c8), w1b = *(const f32x4*)(cw + 1024 + c8 + 4), w2a = *(const f32x4*)(cw + 2048 + c8), w2b = *(const f32x4*)(cw + 2048 + c8 + 4);
    for (int m = F.wg * 4 + (F.tid >> 7); m < M; m += F.G * 4) {
        const int s = m & (SEQ - 1); const size_t off = (size_t)m * 1024 + c8;
        f32x4 a0, a1, b0, b1, c0, c1, g0, g1;
        unpack8bf(*(const u32x4*)(CU + off), c0, c1);
        if (s >= 1) unpack8bf(*(const u32x4*)(CU + off - 1024), b0, b1); else { b0 = (f32x4){0.f, 0.f, 0.f, 0.f}; b1 = b0; }
        if (s >= 2) unpack8bf(*(const u32x4*)(CU + off - 2048), a0, a1); else { a0 = (f32x4){0.f, 0.f, 0.f, 0.f}; a1 = a0; }
        unpack8bf(*(const u32x4*)(GB + off), g0, g1);
        { const f32x4 r0 = g0 * (w0a * a0 + w1a * b0 + w2a * c0) * GB8_SCALE, r1 = g1 * (w0b * a1 + w1b * b1 + w2b * c1) * GB8_SCALE;
          *(u32x2*)(F.ws + WS_GB8 + off) = (u32x2){pk4_fp8(sat8(r0[0]), sat8(r0[1]), sat8(r0[2]), sat8(r0[3])), pk4_fp8(sat8(r1[0]), sat8(r1[1]), sat8(r1[2]), sat8(r1[3]))}; }
    }
}
__device__ __forceinline__ size_t sc_row_off(int b, int s) { const int c = s >> 6; return (size_t)b * SC_BATCH + (size_t)2048 * c * (c + 1) + (size_t)(s & 63) * 64 * (c + 1); }
__device__ __forceinline__ unsigned sortable_pk(float a, float b) {
    typedef __fp16 h2 __attribute__((ext_vector_type(2)));
    const h2 h = __builtin_amdgcn_cvt_pkrtz(a, b); const unsigned u = __builtin_bit_cast(unsigned, h);
    const s16x2 sv = __builtin_bit_cast(s16x2, u); const s16x2 sg = sv >> 15; const unsigned m = __builtin_bit_cast(unsigned, sg);
    return u ^ (m | 0x80008000u);
}
__device__ __forceinline__ void indexer_chunk(const Frame& F, int b, int c) {
    if (c < 4) return;
    const unsigned char* QI = F.ws + WS_QI; const unsigned char* KI = F.ws + WS_KI; const float* WI = (const float*)(F.ws + WS_WI);
    unsigned short* SC = (unsigned short*)(F.ws + WS_SC);
    const int L = 64 * (c + 1), qg = F.wave & 1, kh = F.wave >> 1, n = F.lane & 31, g = F.lane >> 5;
    const int sq = 64 * c + 32 * qg + n; const size_t mq = (size_t)b * SEQ + sq;
    i32x8 qf[16];
#pragma unroll
    for (int h = 0; h < 16; ++h) { const unsigned char* qp = QI + mq * 1024 + h * 64 + 32 * g; qf[h] = __builtin_shufflevector(*(const i32x4*)qp, *(const i32x4*)(qp + 16), 0, 1, 2, 3, 4, 5, 6, 7); }
    float w[16];
#pragma unroll
    for (int j = 0; j < 4; ++j) { const f32x4 t4 = *(const f32x4*)(WI + mq * 16 + 4 * j) * (1.0f / (QKV8_SCALE * QKV8_SCALE)); w[4 * j] = t4[0]; w[4 * j + 1] = t4[1]; w[4 * j + 2] = t4[2]; w[4 * j + 3] = t4[3]; }
    unsigned short* srow = SC + sc_row_off(b, sq) + 4 * g;
    const unsigned char* kp = KI + ((size_t)b * SEQ + n) * 64 + 32 * g;
    const int nt = L / 32;
    if (kh >= nt) return;
    i32x8 a = __builtin_shufflevector(*(const i32x4*)(kp + (size_t)(32 * kh) * 64), *(const i32x4*)(kp + (size_t)(32 * kh) * 64 + 16), 0, 1, 2, 3, 4, 5, 6, 7);
    for (int t = kh; t < nt; t += 4) {
        const int tn = (t + 4 < nt) ? t + 4 : t;
        const i32x8 na = __builtin_shufflevector(*(const i32x4*)(kp + (size_t)(32 * tn) * 64), *(const i32x4*)(kp + (size_t)(32 * tn) * 64 + 16), 0, 1, 2, 3, 4, 5, 6, 7);
        __builtin_amdgcn_sched_barrier(0);
        f32x2 s[8];
#pragma unroll
        for (int i = 0; i < 8; ++i) s[i] = (f32x2){0.f, 0.f};
#pragma unroll
        for (int h = 0; h < 16; ++h) {
            const f32x16 acc = __builtin_amdgcn_mfma_scale_f32_32x32x64_f8f6f4(a, qf[h], f32x16{}, 0, 0, 0, 0, 0, 0);
#pragma unroll
            for (int i = 0; i < 8; ++i) {
                const float x0 = acc[2 * i], x1 = acc[2 * i + 1]; const int i0 = (int)__float_as_uint(x0), i1 = (int)__float_as_uint(x1);
                const float r0 = __uint_as_float((unsigned)(i0 > 0 ? i0 : 0)), r1 = __uint_as_float((unsigned)(i1 > 0 ? i1 : 0));
                s[i] = __builtin_elementwise_fma((f32x2){r0, r1}, (f32x2){w[h], w[h]}, s[i]); }
        }
#pragma unroll
        for (int a4 = 0; a4 < 4; ++a4) *(u32x2*)(srow + 32 * t + 8 * a4) = (u32x2){sortable_pk(s[2 * a4][0], s[2 * a4][1]), sortable_pk(s[2 * a4 + 1][0], s[2 * a4 + 1][1])};
        a = na;
    }
}
__device__ __forceinline__ void indexer_phase(const Frame& F) {
    for (int it = F.wg; it < 256; it += F.G) { const int b = it >> 7, j = it & 127; indexer_chunk(F, b, j); indexer_chunk(F, b, 255 - j); }
}
__device__ __forceinline__ int wave_excl_suffix(int v, int lane) {
    int x = v;
#pragma unroll
    for (int d = 1; d < 64; d <<= 1) { const int y = __shfl_down(x, d); if (lane + d < 64) x += y; }
    return x - v;
}
__device__ __forceinline__ int wave_excl_prefix(int v, int lane) {
    int x = v;
#pragma unroll
    for (int d = 1; d < 64; d <<= 1) { const int y = __shfl_up(x, d); if (lane >= d) x += y; }
    return x - v;
}
__device__ __forceinline__ void hist_find(LAS unsigned* hist, int need, int lane, int& bin, int& above, int& inbin) {
    const u32x4 q0 = *(const LAS u32x4*)(hist + 16 * lane), q1 = *(const LAS u32x4*)(hist + 16 * lane + 4), q2 = *(const LAS u32x4*)(hist + 16 * lane + 8), q3 = *(const LAS u32x4*)(hist + 16 * lane + 12);
    const int c0 = (int)(q0.x + q0.y + q0.z + q0.w), c1 = (int)(q1.x + q1.y + q1.z + q1.w), c2 = (int)(q2.x + q2.y + q2.z + q2.w), c3 = (int)(q3.x + q3.y + q3.z + q3.w);
    const int A = wave_excl_suffix(c0 + c1 + c2 + c3, lane);
    int fb = -1, fa = 0, fc = 0;
    { int a = A; if (a < need && need <= a + c3) { fb = 4 * lane + 3; fa = a; fc = c3; } a += c3;
      if (a < need && need <= a + c2) { fb = 4 * lane + 2; fa = a; fc = c2; } a += c2;
      if (a < need && need <= a + c1) { fb = 4 * lane + 1; fa = a; fc = c1; } a += c1;
      if (a < need && need <= a + c0) { fb = 4 * lane + 0; fa = a; fc = c0; } }
    const unsigned long long bal = __ballot(fb >= 0);
    const int src = bal ? (int)__builtin_ctzll(bal) : 0;
    bin = __shfl(fb, src); above = __shfl(fa, src); inbin = __shfl(fc, src);
}
__device__ __forceinline__ void select_query(const Frame& F, int b, int s, LAS unsigned* hist) {
    const int lane = F.lane, c = s >> 6, L = 64 * (c + 1), G = L >> 5, Gend = 8 * ((s >> 8) + 1);
    unsigned* MK = (unsigned*)(F.ws + WS_MASK) + (size_t)b * 512 * SEQ + s;
    if (L <= 256) { for (int g = lane; g < Gend; g += 64) MK[(size_t)g * SEQ] = (g < G) ? 0xFFFFFFFFu : 0u; return; }
    const unsigned short* row = (const unsigned short*)(F.ws + WS_SC) + sc_row_off(b, s);
    u32x4 d[8][4];
#pragma unroll
    for (int j = 0; j < 8; ++j) { const int g = lane + 64 * j; const u32x4* p = (const u32x4*)(row + g * 32);
#pragma unroll
        for (int q = 0; q < 4; ++q) d[j][q] = (g < G) ? p[q] : (u32x4){0u, 0u, 0u, 0u}; }
    const int l3 = lane & 3;
#pragma unroll
    for (int z = 0; z < 4; ++z) *(LAS u32x4*)(hist + 16 * lane + 4 * z) = (u32x4){0u, 0u, 0u, 0u};
    LDS_WAIT();
#pragma unroll
    for (int j = 0; j < 8; ++j) if (64 * j < G) { if (lane + 64 * j < G) {
#pragma unroll
        for (int q = 0; q < 4; ++q)
#pragma unroll
            for (int i = 0; i < 4; ++i) { const unsigned v = d[j][q][i]; __hip_atomic_fetch_add(hist + ((v >> 6) & 0x3fcu) + l3, 1u, __ATOMIC_RELAXED, __HIP_MEMORY_SCOPE_WORKGROUP); __hip_atomic_fetch_add(hist + ((v >> 22) & 0x3fcu) + l3, 1u, __ATOMIC_RELAXED, __HIP_MEMORY_SCOPE_WORKGROUP); } } __builtin_amdgcn_sched_barrier(0); }
    LDS_WAIT();
    int b1, above1, in1; hist_find(hist, 256, lane, b1, above1, in1);
    const int need2 = 256 - above1;
    LDS_WAIT();
#pragma unroll
    for (int z = 0; z < 4; ++z) *(LAS u32x4*)(hist + 16 * lane + 4 * z) = (u32x4){0u, 0u, 0u, 0u};
    LDS_WAIT();
#pragma unroll
    for (int j = 0; j < 8; ++j) if (64 * j < G) { if (lane + 64 * j < G) {
#pragma unroll
        for (int q = 0; q < 4; ++q)
#pragma unroll
            for (int i = 0; i < 4; ++i) { const unsigned v = d[j][q][i];
                if (((v >> 8) & 0xffu) == (unsigned)b1) __hip_atomic_fetch_add(hist + ((v & 0xffu) << 2) + l3, 1u, __ATOMIC_RELAXED, __HIP_MEMORY_SCOPE_WORKGROUP);
                if ((v >> 24) == (unsigned)b1) __hip_atomic_fetch_add(hist + ((v >> 14) & 0x3fcu) + l3, 1u, __ATOMIC_RELAXED, __HIP_MEMORY_SCOPE_WORKGROUP); } } __builtin_amdgcn_sched_barrier(0); }
    LDS_WAIT();
    int b2, above2, in2; hist_find(hist, need2, lane, b2, above2, in2);
    const unsigned T = ((unsigned)b1 << 8) | (unsigned)b2;
    const int rem = need2 - above2;
    const bool all_eq = (rem >= in2);
    int base = 0;
#pragma unroll
    for (int j = 0; j < 8; ++j) if (64 * j < G) {
        const int g = lane + 64 * j; unsigned gt = 0u, eq = 0u;
#pragma unroll
        for (int q = 0; q < 4; ++q)
#pragma unroll
            for (int i = 0; i < 4; ++i) { const unsigned v = d[j][q][i], lo = v & 0xffffu, hi = v >> 16; const int bit = 8 * q + 2 * i;
                gt |= (lo > T ? 1u : 0u) << bit; gt |= (hi > T ? 1u : 0u) << (bit + 1); eq |= (lo == T ? 1u : 0u) << bit; eq |= (hi == T ? 1u : 0u) << (bit + 1); }
        if (g >= G) { gt = 0u; eq = 0u; }
        unsigned word = gt | eq;
        if (!all_eq) {
            const int cnt = __builtin_popcount(eq); const int pre = wave_excl_prefix(cnt, lane); const int tot = __shfl(pre + cnt, 63);
            int allow = rem - base - pre; allow = allow < 0 ? 0 : (allow > cnt ? cnt : allow);
            unsigned keep = 0u, mm = eq; for (int k = 0; k < allow; ++k) { const unsigned low = mm & (0u - mm); keep |= low; mm ^= low; }
            word = gt | keep; base += tot;
        }
        if (g < G) MK[(size_t)g * SEQ] = word;
        __builtin_amdgcn_sched_barrier(0);
    }
    for (int g = G + lane; g < Gend; g += 64) MK[(size_t)g * SEQ] = 0u;
}
__device__ __forceinline__ void select_phase(const Frame& F) {
    LAS unsigned* hist = (LAS unsigned*)(F.lds + F.wave * 4096);
    const int gw = F.wg * NWAVES + F.wave, NGW = F.G * NWAVES;
    (void)gw; (void)NGW;
    for (int it = F.wg; it < 256; it += F.G) { const int b = it >> 7, j = it & 127;
#pragma unroll 1
        for (int t = 0; t < 16; ++t) { const int cc = (t & 8) ? 255 - j : j; select_query(F, b, 64 * cc + (t & 7) * 8 + F.wave, hist); } }
}
__device__ __forceinline__ void ln1_router_phase(const Frame& F) {
    const float* Y = (const float*)(F.ws + WS_Y1); bf16_t* H1B = (bf16_t*)(F.ws + WS_H1B); bf16_t* H1L = (bf16_t*)(F.ws + WS_H1L);
    const float* g = F.inp(I_LN1G); const float* bb = F.inp(I_LN1B); const float* br = F.inp(I_BR);
    const int lane = F.lane, gw = F.wg * NWAVES + F.wave;
    for (int rr = 0; rr < 16; ++rr) {
        const int m = gw * 16 + rr; const float* yr = Y + (size_t)m * D + 4 * lane; f32x4 v[8]; float s = 0.f;
#pragma unroll
        for (int j = 0; j < 8; ++j) { v[j] = __builtin_nontemporal_load((const f32x4*)(yr + 256 * j)); s += (v[j][0] + v[j][1]) + (v[j][2] + v[j][3]); }
        const float mean = wave_sum(s) * (1.f / D); float s2 = 0.f;
#pragma unroll
        for (int j = 0; j < 8; ++j) { v[j] = v[j] - mean; s2 += (v[j][0] * v[j][0] + v[j][1] * v[j][1]) + (v[j][2] * v[j][2] + v[j][3] * v[j][3]); }
        const float rs = 1.f / sqrtf(wave_sum(s2) * (1.f / D) + LN_EPS);
        bf16_t* hb = H1B + (size_t)m * D + 4 * lane; bf16_t* hl = H1L + (size_t)m * D + 4 * lane; unsigned char* hf = F.ws + WS_H1F + (size_t)m * D + 4 * lane;
#pragma unroll
        for (int j = 0; j < 8; ++j) { const f32x4 y = v[j] * rs * *(const f32x4*)(g + 4 * lane + 256 * j) + *(const f32x4*)(bb + 4 * lane + 256 * j);
            const unsigned h01 = pk2(y[0], y[1]), h23 = pk2(y[2], y[3]);
            *(u32x2*)(hb + 256 * j) = (u32x2){h01, h23};
            *(unsigned*)(hf + 256 * j) = pk4_fp8(sat8(y[0] * ACT8_H1), sat8(y[1] * ACT8_H1), sat8(y[2] * ACT8_H1), sat8(y[3] * ACT8_H1));
            *(u32x2*)(hl + 256 * j) = (u32x2){pk2(y[0] - bf_lo(h01), y[1] - bf_hi(h01)), pk2(y[2] - bf_lo(h23), y[3] - bf_hi(h23))}; }
    }
    asm volatile("s_waitcnt vmcnt(0)" ::: "memory");
    const int j = lane & 15, gq = lane >> 4;
    const bf16_t* WRH = (const bf16_t*)(F.ws + WS_WRH); const bf16_t* WRL = (const bf16_t*)(F.ws + WS_WRL);
    const bf16_t* ah = H1B + (size_t)(gw * 16 + j) * D + gq * 8; const bf16_t* al = H1L + (size_t)(gw * 16 + j) * D + gq * 8;
    const bf16_t* wh0 = WRH + (size_t)j * D + gq * 8; const bf16_t* wl0 = WRL + (size_t)j * D + gq * 8;
    f32x4 acc0 = {0.f, 0.f, 0.f, 0.f}, acc1 = {0.f, 0.f, 0.f, 0.f};
#pragma unroll 4
    for (int ks = 0; ks < 64; ++ks) {
        const bf16x8 hh = __builtin_nontemporal_load((const bf16x8*)(ah + ks * 32)), hl2 = __builtin_nontemporal_load((const bf16x8*)(al + ks * 32));
        const bf16x8 w0h = *(const bf16x8*)(wh0 + ks * 32), w1h = *(const bf16x8*)(wh0 + 16 * D + ks * 32), w0l = *(const bf16x8*)(wl0 + ks * 32), w1l = *(const bf16x8*)(wl0 + 16 * D + ks * 32);
        acc0 = __builtin_amdgcn_mfma_f32_16x16x32_bf16(w0h, hh, acc0, 0, 0, 0); acc1 = __builtin_amdgcn_mfma_f32_16x16x32_bf16(w1h, hh, acc1, 0, 0, 0);
        acc0 = __builtin_amdgcn_mfma_f32_16x16x32_bf16(w0l, hh, acc0, 0, 0, 0); acc1 = __builtin_amdgcn_mfma_f32_16x16x32_bf16(w1l, hh, acc1, 0, 0, 0);
        acc0 = __builtin_amdgcn_mfma_f32_16x16x32_bf16(w0h, hl2, acc0, 0, 0, 0); acc1 = __builtin_amdgcn_mfma_f32_16x16x32_bf16(w1h, hl2, acc1, 0, 0, 0);
    }
    float lv[8]; { const f32x4 b0 = *(const f32x4*)(br + 4 * gq), b1 = *(const f32x4*)(br + 16 + 4 * gq);
#pragma unroll
      for (int r = 0; r < 4; ++r) { lv[r] = acc0[r] + b0[r]; lv[4 + r] = acc1[r] + b1[r]; } }
    int te[4]; float tv[4];
#pragma unroll
    for (int k = 0; k < 4; ++k) {
        float bv = lv[0]; int bi = 4 * gq;
#pragma unroll
        for (int r = 1; r < 8; ++r) { const int idx = (r < 4) ? 4 * gq + r : 16 + 4 * gq + (r - 4); if (lv[r] > bv) { bv = lv[r]; bi = idx; } }
#pragma unroll
        for (int o = 16; o < 64; o <<= 1) { const float ov = __shfl_xor(bv, o); const int oi = __shfl_xor(bi, o); if (ov > bv || (ov == bv && oi < bi)) { bv = ov; bi = oi; } }
        te[k] = bi; tv[k] = bv;
#pragma unroll
        for (int r = 0; r < 8; ++r) { const int idx = (r < 4) ? 4 * gq + r : 16 + 4 * gq + (r - 4); if (idx == bi) lv[r] = -__builtin_inff(); }
    }
    const float e1 = __expf(tv[1] - tv[0]), e2 = __expf(tv[2] - tv[0]), e3 = __expf(tv[3] - tv[0]); const float inv = 1.f / (1.f + e1 + e2 + e3);
    const int m = gw * 16 + j;
    if (gq == 0) { *(int4*)((int*)(F.ws + WS_TOPE) + (size_t)m * 4) = make_int4(te[0], te[1], te[2], te[3]); *(f32x4*)((float*)(F.ws + WS_TOPG) + (size_t)m * 4) = (f32x4){inv, e1 * inv, e2 * inv, e3 * inv}; }
    int cnt = 0;
#pragma unroll 4
    for (int e = 0; e < 32; ++e) { const unsigned long long bal = __ballot(gq == 0 && (te[0] == e || te[1] == e || te[2] == e || te[3] == e)); if (lane == e) cnt = __builtin_popcountll(bal); }
    if (lane < 32) ((int*)(F.ws + WS_WVCNT))[gw * 32 + lane] = cnt;
}
__device__ __forceinline__ void moe_assign_phase(const Frame& F) {
    const int* WV = (const int*)(F.ws + WS_WVCNT); int* EI = (int*)(F.ws + WS_EXPINFO);
    LAS int* part_all = (LAS int*)F.lds;
    LAS int* part_bef = part_all + 512;
    LAS int* tot = part_bef + 512;
    LAS int* bef = tot + 32;
    LAS int* pst = bef + 32;
    LAS int* wbase = pst + 32;
    const int tid = F.tid, e = tid & 31, part = tid >> 5, gw0 = F.wg * NWAVES;
    { int a = 0, bfr = 0; for (int w = part * 128; w < part * 128 + 128; ++w) { const int v = WV[w * 32 + e]; a += v; if (w < gw0) bfr += v; } part_all[part * 32 + e] = a; part_bef[part * 32 + e] = bfr; }
    __syncthreads();
    if (tid < 32) { int a = 0, bfr = 0; for (int p = 0; p < 16; ++p) { a += part_all[p * 32 + tid]; bfr += part_bef[p * 32 + tid]; } tot[tid] = a; bef[tid] = bfr;
        const int padded = (a + 255) & ~255; int x = padded;
#pragma unroll
        for (int d = 1; d < 32; d <<= 1) { const int y = __shfl_up(x, d); if (tid >= d) x += y; }
        pst[tid] = x - padded;
        if (F.wg == 0) { const int nb0 = (x - padded) >> 8, nb1 = x >> 8; for (int bk = nb0; bk < nb1; ++bk) EI[64 + bk] = tid; if (tid == 31) EI[0] = nb1; } }
    __syncthreads();
    if (tid < 256) { const int w = tid >> 5; int a = pst[e] + bef[e]; for (int w2 = 0; w2 < w; ++w2) a += WV[(gw0 + w2) * 32 + e]; wbase[w * 32 + e] = a; }
    __syncthreads();
    int* ROWTOK = (int*)(F.ws + WS_ROWTOK); float* ROWW = (float*)(F.ws + WS_ROWW); int* SLOT = (int*)(F.ws + WS_SLOT);
    if (F.wg < 32 && tid < 256) { const int ex = F.wg, a = tot[ex], p0 = pst[ex] + a, p1 = pst[ex] + ((a + 255) & ~255); if (p0 + tid < p1) { ROWTOK[p0 + tid] = 0; ROWW[p0 + tid] = 0.f; } }
    { const int lane = F.lane, m = (gw0 + F.wave) * 16 + (lane >> 2), k = lane & 3;
      const int ex = ((const int*)(F.ws + WS_TOPE))[(size_t)m * 4 + k]; const float gt = ((const float*)(F.ws + WS_TOPG))[(size_t)m * 4 + k];
      int rank = 0;
#pragma unroll 4
      for (int q = 0; q < 32; ++q) { const unsigned long long bal = __ballot(ex == q); if (ex == q) rank = __builtin_popcountll(bal & ((1ull << lane) - 1ull)); }
      const int dest = wbase[F.wave * 32 + ex] + rank;
      ROWTOK[dest] = m; ROWW[dest] = gt; SLOT[(size_t)m * 4 + k] = dest; }
    __syncthreads();
}
__device__ __forceinline__ void final_phase(const Frame& F, bool poison, float oscale) {
    const bf16_t* H1B = (const bf16_t*)(F.ws + WS_H1B); const unsigned char* OW = F.ws + WS_OW; const bf16_t* PLE = (const bf16_t*)(F.ws + WS_PLE); const int* SLOT = (const int*)(F.ws + WS_SLOT);
    const float* g = F.inp(I_LN2G); const float* bb = F.inp(I_LN2B); const int lane = F.lane, gw = F.wg * NWAVES + F.wave, NGW = F.G * NWAVES;
    for (int m = gw; m < M; m += NGW) {
        const int4 sl = *(const int4*)(SLOT + (size_t)m * 4);
        f32x4 v[8]; float s = 0.f;
#pragma unroll
        for (int j = 0; j < 8; ++j) {
            const u32x2 hh = __builtin_nontemporal_load((const u32x2*)(H1B + (size_t)m * D + 4 * lane + 256 * j));
            f32x4 a = (f32x4){bf_lo(hh.x), bf_hi(hh.x), bf_lo(hh.y), bf_hi(hh.y)} * DN_ALPHA;
            const u32x2 p = __builtin_nontemporal_load((const u32x2*)(PLE + (size_t)m * D + 4 * lane + 256 * j));
            const int o0 = (int)__builtin_nontemporal_load((const unsigned*)(OW + (size_t)sl.x * D + 4 * lane + 256 * j)), o1 = (int)__builtin_nontemporal_load((const unsigned*)(OW + (size_t)sl.y * D + 4 * lane + 256 * j));
            const int o2 = (int)__builtin_nontemporal_load((const unsigned*)(OW + (size_t)sl.z * D + 4 * lane + 256 * j)), o3 = (int)__builtin_nontemporal_load((const unsigned*)(OW + (size_t)sl.w * D + 4 * lane + 256 * j));
            const f32x2_t e01 = (__builtin_amdgcn_cvt_pk_f32_fp8(o0, false) + __builtin_amdgcn_cvt_pk_f32_fp8(o1, false)) + (__builtin_amdgcn_cvt_pk_f32_fp8(o2, false) + __builtin_amdgcn_cvt_pk_f32_fp8(o3, false));
            const f32x2_t e23 = (__builtin_amdgcn_cvt_pk_f32_fp8(o0, true) + __builtin_amdgcn_cvt_pk_f32_fp8(o1, true)) + (__builtin_amdgcn_cvt_pk_f32_fp8(o2, true) + __builtin_amdgcn_cvt_pk_f32_fp8(o3, true));
            a[0] += e01[0] * (1.0f / OW8_SCALE) + bf_lo(p.x); a[1] += e01[1] * (1.0f / OW8_SCALE) + bf_hi(p.x);
            a[2] += e23[0] * (1.0f / OW8_SCALE) + bf_lo(p.y); a[3] += e23[1] * (1.0f / OW8_SCALE) + bf_hi(p.y);
            v[j] = a; s += (a[0] + a[1]) + (a[2] + a[3]); }
        const float mean = wave_sum(s) * (1.f / D); float s2 = 0.f;
#pragma unroll
        for (int j = 0; j < 8; ++j) { v[j] = v[j] - mean; s2 += (v[j][0] * v[j][0] + v[j][1] * v[j][1]) + (v[j][2] * v[j][2] + v[j][3] * v[j][3]); }
        const float rs = 1.f / sqrtf(wave_sum(s2) * (1.f / D) + LN_EPS);
        float* orow = F.out + (size_t)m * D + 4 * lane;
#pragma unroll
        for (int j = 0; j < 8; ++j) { f32x4 y = v[j] * rs * *(const f32x4*)(g + 4 * lane + 256 * j) + *(const f32x4*)(bb + 4 * lane + 256 * j);
            y = y * oscale;
            if (poison) y = (f32x4){__builtin_nanf(""), __builtin_nanf(""), __builtin_nanf(""), __builtin_nanf("")};
            __builtin_nontemporal_store(y, (f32x4*)(orow + 256 * j)); }
    }
}
namespace att {
constexpr int Dh = 128, NW = 8, QBLK = 32, KVBLK = 64, QB = NW * QBLK;
constexpr int SHM_K = KVBLK * Dh, SHM_V = Dh * KVBLK;
constexpr int BIAS_OFF = 2 * SHM_V + 2 * SHM_K + NW * 64 * 4;
constexpr int PEN_OFF = BIAS_OFF + 8 * 256 * 4;
constexpr int ATT_LDS = PEN_OFF + 256;
constexpr float QKV8 = QKV8_SCALE;
constexpr float SCALE = ATT_SCALE / (QKV8 * QKV8), THR = 2.f;
constexpr float PEXP = 5.f;
#define SBAR() __builtin_amdgcn_sched_barrier(0)
__device__ __forceinline__ int crow(int r, int hi) { return (r & 3) + 8 * (r >> 2) + 4 * hi; }

__device__ __forceinline__ void mask_tile(f32x16& p0, f32x16& p1, unsigned w0, unsigned w1) {
#pragma unroll
    for (int r = 0; r < 16; ++r) { const int c = (r & 3) + 8 * (r >> 2);
        const unsigned m0 = (unsigned)((int)(w0 << (31 - c)) >> 31), m1 = (unsigned)((int)(w1 << (31 - c)) >> 31);
        p0[r] = __uint_as_float((__float_as_uint(p0[r]) & m0) | (0xFF800000u & ~m0));
        p1[r] = __uint_as_float((__float_as_uint(p1[r]) & m1) | (0xFF800000u & ~m1)); }
}
__device__ __forceinline__ void bias_tile(f32x16& p0, f32x16& p1, const LAS float* tab, int rel0) {
#pragma unroll
    for (int r = 0; r < 16; ++r) { const int c = (r & 3) + 8 * (r >> 2); int i0 = rel0 + c, i1 = rel0 + c + 32;
        i0 = i0 < 0 ? 0 : (i0 > 255 ? 255 : i0); i1 = i1 < 0 ? 0 : (i1 > 255 ? 255 : i1);
        p0[r] += tab[i0]; p1[r] += tab[i1]; }
}
__device__ __forceinline__ void partialSM(f32x16& p0, f32x16& p1, float& m_reg, float& mn, float& alpha) {
    float pmax = p0[0];
#pragma unroll
    for (int r = 1; r < 16; ++r) pmax = fmaxf(pmax, p0[r]);
#pragma unroll
    for (int r = 0; r < 16; ++r) pmax = fmaxf(pmax, p1[r]);
    { auto rr = __builtin_amdgcn_permlane32_swap(__float_as_uint(pmax), __float_as_uint(pmax), false, false);
      pmax = fmaxf(__uint_as_float(rr[0]), __uint_as_float(rr[1])); }
    constexpr float C2 = 1.4426950408889634f * SCALE;
    if (__builtin_expect(__all((pmax - m_reg) * SCALE <= THR), 1)) { mn = m_reg; alpha = 1.f; }
    else { mn = fmaxf(m_reg, pmax); alpha = __builtin_amdgcn_exp2f((m_reg - mn) * C2); m_reg = mn; }
    const float mnL = -mn * C2 + PEXP;
#pragma unroll
    for (int r = 0; r < 16; r += 2) { const f32x2 v = __builtin_elementwise_fma((f32x2){p0[r], p0[r + 1]}, (f32x2){C2, C2}, (f32x2){mnL, mnL}); p0[r] = v[0]; p0[r + 1] = v[1]; }
#pragma unroll
    for (int r = 0; r < 16; r += 2) { const f32x2 v = __builtin_elementwise_fma((f32x2){p1[r], p1[r + 1]}, (f32x2){C2, C2}, (f32x2){mnL, mnL}); p1[r] = v[0]; p1[r + 1] = v[1]; }
#pragma unroll
    for (int r = 0; r < 16; ++r) p0[r] = __builtin_amdgcn_exp2f(p0[r]);
}
__device__ __forceinline__ void finishSM(f32x16& p0, f32x16& p1, float alpha, float& l_reg, i32x8& pa) {
#pragma unroll
    for (int r = 0; r < 16; ++r) p1[r] = __builtin_amdgcn_exp2f(p1[r]);
    f32x2 sa = {p0[0], p0[1]}, sb = {p1[0], p1[1]};
#pragma unroll
    for (int r = 2; r < 16; r += 2) { sa += (f32x2){p0[r], p0[r + 1]}; sb += (f32x2){p1[r], p1[r + 1]}; }
    sa += sb;
    float ps = sa[0] + sa[1];
    { auto rr = __builtin_amdgcn_permlane32_swap(__float_as_uint(ps), __float_as_uint(ps), false, false);
      ps = __uint_as_float(rr[0]) + __uint_as_float(rr[1]); }
    l_reg = l_reg * alpha + ps;
#pragma unroll
    for (int w = 0; w < 4; ++w) { pa[w] = (int)pk4_fp8(p0[4 * w], p0[4 * w + 1], p0[4 * w + 2], p0[4 * w + 3]); pa[4 + w] = (int)pk4_fp8(p1[4 * w], p1[4 * w + 1], p1[4 * w + 2], p1[4 * w + 3]); }
}
__device__ __forceinline__ i32x8 cat8(const i32x4 lo, const i32x4 hi) { return __builtin_shufflevector(lo, hi, 0, 1, 2, 3, 4, 5, 6, 7); }
template <int KB>
__device__ __forceinline__ void qkt(f32x16& p0, f32x16& p1, const char* K_lds, int r32, int hi, const i32x8* qr, unsigned w0, unsigned w1, const char* pen) {
#pragma unroll
    for (int g = 0; g < 4; ++g) { const f32x4 e0 = *reinterpret_cast<const f32x4*>(pen + (((w0 >> (8 * g)) & 15u) << 4)), e1 = *reinterpret_cast<const f32x4*>(pen + (((w1 >> (8 * g)) & 15u) << 4));
        p0[4 * g] = e0[0]; p0[4 * g + 1] = e0[1]; p0[4 * g + 2] = e0[2]; p0[4 * g + 3] = e0[3]; p1[4 * g] = e1[0]; p1[4 * g + 1] = e1[1]; p1[4 * g + 2] = e1[2]; p1[4 * g + 3] = e1[3]; }
    const char* a = K_lds + KB * SHM_K + r32 * 128; const int sw = r32 & 7;
#pragma unroll
    for (int s = 0; s < 2; ++s) { const int c0 = ((4 * s + 2 * hi) ^ sw) << 4, c1 = ((4 * s + 2 * hi + 1) ^ sw) << 4;
        const i32x8 k0 = cat8(*reinterpret_cast<const i32x4*>(a + c0), *reinterpret_cast<const i32x4*>(a + c1));
        const i32x8 k1 = cat8(*reinterpret_cast<const i32x4*>(a + 32 * 128 + c0), *reinterpret_cast<const i32x4*>(a + 32 * 128 + c1));
        p0 = __builtin_amdgcn_mfma_scale_f32_32x32x64_f8f6f4(k0, qr[s], p0, 0, 0, 0, 0, 0, 0);
        p1 = __builtin_amdgcn_mfma_scale_f32_32x32x64_f8f6f4(k1, qr[s], p1, 0, 0, 0, 0, 0, 0); }
}
template <int VB>
__device__ __forceinline__ void pv_tile(f32x16* o, const char* V_lds, int r32, int hi, const i32x8 pa) {
#pragma unroll
    for (int db = 0; db < 4; ++db) { const int d = 32 * db + r32, sw = (d >> 1) & 3; const char* a = V_lds + VB * SHM_V + d * 64;
        const i32x8 v = cat8(*reinterpret_cast<const i32x4*>(a + (((2 * hi) ^ sw) << 4)), *reinterpret_cast<const i32x4*>(a + (((2 * hi + 1) ^ sw) << 4)));
        o[db] = __builtin_amdgcn_mfma_scale_f32_32x32x64_f8f6f4(pa, v, o[db], 0, 0, 0, 0, 0, 0); }
}
struct BlockRef { const unsigned char* Q; const unsigned char* K; const unsigned char* VT; unsigned char* O; const unsigned* MK; int P0; int hd; };
struct Seam { i32x8 qr[2]; u32x4 st_k, st_v; };
#define VMW() asm volatile("s_waitcnt vmcnt(0)" ::: "memory")
#define VMWN(n) asm volatile("s_waitcnt vmcnt(%0)" :: "i"(n) : "memory")
#define SLOAD_H(Kp, Vp, k0) do { S.st_v = *reinterpret_cast<const u32x4*>((Vp) + (size_t)((k0) >> 6) * 8192 + vsrc); S.st_k = *reinterpret_cast<const u32x4*>((Kp) + (size_t)(k0) * 128 + ksrc); } while (0)
#define SWRITE_HK(bf) do { *(u32x4*)(K_lds + (bf) * SHM_K + kws) = S.st_k; } while (0)
#define SWRITE_HV(bf) do { *(u32x4*)(V_lds + (bf) * SHM_V + vws) = S.st_v; } while (0)
#define SWRITE_H(bf) do { SWRITE_HV(bf); SWRITE_HK(bf); } while (0)
#define QLOAD(ref) do { _Pragma("unroll") for (int s_ = 0; s_ < 2; ++s_) { const unsigned char* qp_ = (ref).Q + (size_t)(wid * QBLK + r32) * 128 + 64 * s_ + 32 * hi; \
        S.qr[s_] = cat8(*reinterpret_cast<const i32x4*>(qp_), *reinterpret_cast<const i32x4*>(qp_ + 16)); } } while (0)
#define MLOAD(ref, t, W0, W1) do { const unsigned* mp_ = (ref).MK + (size_t)(2 * (t)) * SEQ + wid * QBLK + r32; W0 = mp_[0]; W1 = mp_[SEQ]; } while (0)
#define ATT_TID() int tid = threadIdx.x; asm volatile("" : "+v"(tid)); \
    const int wid = __builtin_amdgcn_readfirstlane(tid >> 6), lane = tid & 63, r32 = lane & 31, hi = lane >> 5; (void)lane; \
    const int kr = tid >> 3, kc = tid & 7, ksrc = kr * 128 + kc * 16, kws = kr * 128 + ((kc ^ (kr & 7)) << 4); \
    const int vd = tid >> 2, vc = tid & 3, vsrc = vd * 64 + vc * 16, vws = vd * 64 + ((vc ^ ((vd >> 1) & 3)) << 4)
__device__ __forceinline__ void prime(const BlockRef& cur, char* lds, Seam& S) {
    ATT_TID(); (void)vws; char* K_lds = lds + 2 * SHM_V;
    QLOAD(cur);
    SLOAD_H(cur.K, cur.VT, 0); VMW(); SWRITE_HK(0);
    __syncthreads();
}
__device__ __forceinline__ void block(const BlockRef& cur, const BlockRef& nxt, char* lds, Seam& S) {
    ATT_TID();
    const int NT = cur.P0 / KVBLK + 4;
    const int qlo = cur.P0 + wid * QBLK, qpos = qlo + r32;
    char* V_lds = lds; char* K_lds = lds + 2 * SHM_V;
    float* ws = (float*)(lds + 2 * SHM_V + 2 * SHM_K) + wid * 64; float* li_l = ws, * al_l = ws + 32;
    const LAS float* btab = (const LAS float*)(lds + BIAS_OFF) + cur.hd * 256; const char* pen = lds + PEN_OFF;
    float m_reg = -1e30f, l_reg = 0; f32x16 o[4] = {};
    const unsigned char* Kh = cur.K; const unsigned char* Vh = cur.VT;
    unsigned mkA0, mkA1, mkB0, mkB1;
    MLOAD(cur, 0, mkA0, mkA1);
#define RESC(a) do { if (__any((a) < 1.f)) { if (hi == 0) al_l[r32] = (a); asm volatile("s_waitcnt lgkmcnt(0)" ::: "memory");              \
                     for (int d_ = 0; d_ < 4; ++d_) for (int r = 0; r < 16; ++r) o[d_][r] *= al_l[crow(r, hi)]; } } while (0)
#define KBASE(t) ((t) * KVBLK)
#define MASKT(P0_, P1_, t, W0, W1) do { const int kb_ = KBASE(t); if (kb_ + KVBLK - 1 > qlo - 160) bias_tile(P0_, P1_, btab, kb_ + 4 * hi - qpos + 192); } while (0)
    f32x16 pA0, pA1, pB0, pB1; float mnA, mnB, alA, alB; i32x8 pa;
    u32x4 ak, av, bk, bv;
#define GLOAD(SK, SV, k0) do { SV = *reinterpret_cast<const u32x4*>(Vh + (size_t)((k0) >> 6) * 8192 + vsrc); SK = *reinterpret_cast<const u32x4*>(Kh + (size_t)(k0) * 128 + ksrc); } while (0)
#define LWRITE(SK, SV, bf) do { *(u32x4*)(V_lds + (bf) * SHM_V + vws) = SV; *(u32x4*)(K_lds + (bf) * SHM_K + kws) = SK; } while (0)
    SWRITE_HV(0); SBAR();
    MLOAD(cur, 1, mkB0, mkB1); GLOAD(bk, bv, KBASE(1)); GLOAD(ak, av, KBASE(2));
    SBAR(); qkt<0>(pA0, pA1, K_lds, r32, hi, S.qr, mkA0 >> (4 * hi), mkA1 >> (4 * hi), pen);
    MASKT(pA0, pA1, 0, mkA0, mkA1); partialSM(pA0, pA1, m_reg, mnA, alA);
    LWRITE(bk, bv, 1);
    __syncthreads();
#define HALF_STEP(PX0, PX1, mnX, alX, PY0, PY1, alY, t, KB, VB, SB, WX0, WX1, WN0, WN1, LK, LV, WK, WV) do {                                  \
        SBAR(); qkt<KB>(PX0, PX1, K_lds, r32, hi, S.qr, (WX0) >> (4 * hi), (WX1) >> (4 * hi), pen);                                           \
        finishSM(PY0, PY1, alY, l_reg, pa); SBAR();                                                           \
        if ((t) + 2 < NT) { GLOAD(LK, LV, KBASE((t) + 2)); SBAR(); }                                                           \
        pv_tile<VB>(o, V_lds, r32, hi, pa); MASKT(PX0, PX1, (t), WX0, WX1); if ((t) + 1 < NT) MLOAD(cur, (t) + 1, WN0, WN1); partialSM(PX0, PX1, m_reg, mnX, alX);              \
        __syncthreads();                                                                                                      \
        if ((t) + 1 < NT) { LWRITE(WK, WV, SB); }                                                                          \
        RESC(alX); __syncthreads(); } while (0)
    for (int t = 1; t + 1 < NT; t += 2) {
        HALF_STEP(pB0, pB1, mnB, alB, pA0, pA1, alA, t, 1, 0, 0, mkB0, mkB1, mkA0, mkA1, bk, bv, ak, av);
        HALF_STEP(pA0, pA1, mnA, alA, pB0, pB1, alB, t + 1, 0, 1, 1, mkA0, mkA1, mkB0, mkB1, ak, av, bk, bv);
    }
#undef GLOAD
#undef LWRITE
    SBAR(); qkt<1>(pB0, pB1, K_lds, r32, hi, S.qr, mkB0 >> (4 * hi), mkB1 >> (4 * hi), pen); SBAR();
    SLOAD_H(nxt.K, nxt.VT, 0); SBAR();
    QLOAD(nxt);
    SBAR();
    finishSM(pA0, pA1, alA, l_reg, pa); SBAR();
    pv_tile<0>(o, V_lds, r32, hi, pa);
    MASKT(pB0, pB1, NT - 1, mkB0, mkB1); partialSM(pB0, pB1, m_reg, mnB, alB); __syncthreads(); RESC(alB);
    finishSM(pB0, pB1, alB, l_reg, pa); SBAR(); pv_tile<1>(o, V_lds, r32, hi, pa);
    SBAR(); VMWN(4); SWRITE_HK(0); SBAR();
    if (hi == 0) li_l[r32] = l_reg; asm volatile("s_waitcnt lgkmcnt(0)" ::: "memory");
    float rli[16];
#pragma unroll
    for (int r = 0; r < 16; ++r) rli[r] = __builtin_amdgcn_rcpf(li_l[crow(r, hi)]);
    int loff = hi * 4096 + r32; asm volatile("" : "+v"(loff));
    unsigned char* Ow = cur.O + (size_t)(wid * QBLK) * 1024 + loff;
#pragma unroll
    for (int r = 0; r < 16; ++r) { const int orow = (r & 3) + 8 * (r >> 2);
#pragma unroll
        for (int d0 = 0; d0 < 4; ++d0) { const float v = o[d0][r] * rli[r];
            const int vi = (int)__float_as_uint(v);
            const float v1 = __uint_as_float((unsigned)__builtin_amdgcn_mov_dpp(vi, 0x39, 0xf, 0xf, true)), v2 = __uint_as_float((unsigned)__builtin_amdgcn_mov_dpp(vi, 0x4e, 0xf, 0xf, true)), v3 = __uint_as_float((unsigned)__builtin_amdgcn_mov_dpp(vi, 0x93, 0xf, 0xf, true));
            if ((r32 & 3) == 0) *(unsigned*)(Ow + (size_t)orow * 1024 + d0 * 32) = pk4_fp8(sat8(v), sat8(v1), sat8(v2), sat8(v3)); } }
    __syncthreads();
#undef RESC
#undef KBASE
#undef MASKT
#undef HALF_STEP
}
#undef VMW
#undef VMWN
#undef SLOAD_H
#undef SWRITE_HK
#undef SWRITE_HV
#undef SWRITE_H
#undef QLOAD
#undef MLOAD
#undef ATT_TID
}

__device__ __forceinline__ int t5_bucket(int rel) {
    const int n = rel < 0 ? -rel : rel; const int base = rel > 0 ? 16 : 0;
    if (n < 8) return base + n;
    int lg = 2 + (31 - __builtin_clz((unsigned)(n * n))); if (lg > 15) lg = 15;
    return base + lg;
}
__device__ __forceinline__ void attention_phase(const Frame& F) {
    char* lds = (char*)(uintptr_t)0;
    (void)lds;
    char* shm = (char*)F.lds;
    { const float* rb = F.inp(I_RELB); LAS float* tab = (LAS float*)(F.lds + att::BIAS_OFF);
      if (F.tid < 64) ((LAS float*)(F.lds + att::PEN_OFF))[F.tid] = ((F.tid >> 2) >> (F.tid & 3)) & 1 ? 0.f : -__builtin_inff();
      for (int i = F.tid; i < 8 * 256; i += NTHR) { const int h = i >> 8, rel = (i & 255) - 192; tab[i] = (rb[t5_bucket(rel) * 8 + h] - rb[15 * 8 + h]) * (1.0f / att::SCALE); } }
    __syncthreads();
    const unsigned char* Qb = F.ws + WS_Q; const unsigned char* Kb = F.ws + WS_K; const unsigned char* Vb = F.ws + WS_V;
    unsigned char* ATT = F.ws + WS_ATT; const unsigned* MKb = (const unsigned*)(F.ws + WS_MASK);
    const int xcd = F.wg & 7, idx = F.wg >> 3;
    auto mkref = [&](int blk) -> att::BlockRef {
        const int round = blk >> 1, pass = blk & 1, bh = round * 8 + xcd, b = bh >> 3, h = bh & 7, qb = pass ? idx : 63 - idx;
        att::BlockRef r; const size_t hb = ((size_t)h * M + (size_t)b * SEQ) * 128;
        r.Q = Qb + hb + (size_t)qb * 256 * 128; r.K = Kb + hb; r.VT = Vb + hb; r.O = ATT + ((size_t)b * SEQ + (size_t)qb * 256) * 1024 + h * 128;
        r.MK = MKb + (size_t)b * 512 * SEQ + qb * 256; r.P0 = qb * 256; r.hd = h; return r; };
    att::Seam S;
    att::BlockRef cur = mkref(0);
    att::prime(cur, shm, S);
#pragma unroll 1
    for (int blk = 0; blk < 4; ++blk) {
        const att::BlockRef nxt = mkref(blk < 3 ? blk + 1 : blk);
        att::block(cur, nxt, shm, S);
        cur = nxt;
    }
    VM_WAIT(); __syncthreads();
}
#ifdef SELFCHECK
constexpr int CW_EATT = 8192, CW_ECNT = 8256, CW_ESEL = 8320;
__device__ __forceinline__ float wave_max(float v) {
#pragma unroll
    for (int o = 1; o < 64; o <<= 1) v = fmaxf(v, __shfl_xor(v, o));
    return v;
}
__device__ __forceinline__ float wave_min(float v) {
#pragma unroll
    for (int o = 1; o < 64; o <<= 1) v = fminf(v, __shfl_xor(v, o));
    return v;
}
__device__ __forceinline__ float bfv(const bf16_t* p) { return __builtin_bit_cast(float, (unsigned)(*p) << 16); }
__device__ __forceinline__ float f8v(const unsigned char* p) { const int w = (int)(*p); return __builtin_amdgcn_cvt_f32_fp8(w, 0) * (1.0f / QKV8_SCALE); }
__device__ __forceinline__ void selfcheck_phase(const unsigned char* ws, const float* relb, unsigned* ctl, int wg, int wave, int lane, LAS unsigned char* lds) {
    const int gw = wg * 8 + wave;
    const int b = gw & 1, h = (gw >> 1) & 7;
    int s = (int)(((unsigned)gw * 2654435761u) >> 9) & (SEQ - 1);
    if (gw < 128) s = gw * 3;
    if (gw >= 128 && gw < 160) s = SEQ - 1 - (gw - 128) * 7;
    const int m = b * SEQ + s, L = 64 * ((s >> 6) + 1), G = L >> 5, Gend = 8 * ((s >> 8) + 1);
    const unsigned* MK = (const unsigned*)(ws + WS_MASK) + (size_t)b * 512 * SEQ + s;
    int cnt = 0, badbits = 0;
    for (int g = lane; g < Gend; g += 64) { const unsigned w = MK[(size_t)g * SEQ]; if (g < G) cnt += __builtin_popcount(w); else badbits += (w != 0u); }
    cnt = (int)wave_sum((float)cnt); badbits = (int)wave_sum((float)badbits);
    const int want = L < 256 ? L : 256;
    if (lane == 0 && (cnt != want || badbits != 0)) atomicAdd(ctl + CW_ECNT, 1u);
    const unsigned char* Qh = ws + WS_Q + ((size_t)h * M + m) * 128; const unsigned char* Kh = ws + WS_K + ((size_t)h * M + (size_t)b * SEQ) * 128; const unsigned char* Vh = ws + WS_V + ((size_t)h * M + (size_t)b * SEQ) * 128;
    const float q0 = f8v(Qh + 2 * lane), q1 = f8v(Qh + 2 * lane + 1);
    float mrun = -1e30f, lrun = 0.f, o0 = 0.f, o1 = 0.f;
    for (int g = 0; g < G; ++g) {
        unsigned w = MK[(size_t)g * SEQ];
        while (w) { const int bit = __builtin_ctz(w); w &= w - 1u; const int kk = 32 * g + bit;
            const float dot = wave_sum(q0 * f8v(Kh + (size_t)kk * 128 + 2 * lane) + q1 * f8v(Kh + (size_t)kk * 128 + 2 * lane + 1));
            const unsigned char* vt = Vh + (size_t)(kk & ~63) * 128 + vt_pos(kk & 63);
            const float lg = dot * ATT_SCALE + relb[t5_bucket(kk - s) * 8 + h];
            const float mn = fmaxf(mrun, lg), al = __expf(mrun - mn), p = __expf(lg - mn);
            lrun = lrun * al + p; o0 = o0 * al + p * f8v(vt + (2 * lane) * 64); o1 = o1 * al + p * f8v(vt + (2 * lane + 1) * 64); mrun = mn; }
    }
    o0 /= lrun; o1 /= lrun;
    const unsigned char* At = ws + WS_ATT + (size_t)m * 1024 + h * 128;
    const float a0 = f8v(At + 2 * lane), a1 = f8v(At + 2 * lane + 1);
    const float num = wave_sum((o0 - a0) * (o0 - a0) + (o1 - a1) * (o1 - a1)), den = wave_sum(o0 * o0 + o1 * o1);
    const float eatt = sqrtf(num / fmaxf(den, 1e-30f));
    if (lane == 0) atomicMax(ctl + CW_EATT, __float_as_uint(fminf(eatt, 100.f)));
    if ((gw & 3) == 0 && L > 256) {
        LAS unsigned char* ql = (LAS unsigned char*)(lds + wave * 4096);
        const unsigned* QIr = (const unsigned*)(ws + WS_QI + (size_t)m * 1024);
        for (int i = lane; i < 256; i += 64) ((LAS unsigned*)ql)[i] = QIr[i];
        float wv[16];
#pragma unroll
        for (int j = 0; j < 16; ++j) wv[j] = ((const float*)(ws + WS_WI))[(size_t)m * 16 + j];
        LDS_WAIT();
        float smin = 3e38f, umax = -3e38f;
        for (int k = lane; k < L; k += 64) {
            const unsigned char* kr = ws + WS_KI + ((size_t)b * SEQ + k) * 64;
            float kd[64];
#pragma unroll
            for (int j = 0; j < 64; ++j) kd[j] = f8v(kr + j);
            float sc = 0.f;
#pragma unroll 1
            for (int hh = 0; hh < 16; ++hh) { float dot = 0.f;
#pragma unroll
                for (int j = 0; j < 64; ++j) { const int qb_ = (int)ql[hh * 64 + j]; dot = fmaf(__builtin_amdgcn_cvt_f32_fp8(qb_, 0) * (1.0f / QKV8_SCALE), kd[j], dot); }
                sc = fmaf(wv[hh], fmaxf(dot, 0.f), sc); }
            const unsigned w = MK[(size_t)(k >> 5) * SEQ];
            if ((w >> (k & 31)) & 1u) smin = fminf(smin, sc); else umax = fmaxf(umax, sc);
        }
        smin = wave_min(smin); umax = wave_max(umax);
        const float viol = fmaxf(umax - smin, 0.f) / fmaxf(fabsf(smin), 1.f);
        if (lane == 0) atomicMax(ctl + CW_ESEL, __float_as_uint(fminf(viol, 100.f)));
    }
}
#endif
#ifndef WGM_IN
#define WGM_IN 4
#endif
#ifndef WGM_N8
#define WGM_N8 4
#endif
#ifndef WGM_G1
#define WGM_G1 8
#endif
#ifndef WGM_G2
#define WGM_G2 8
#endif
#ifndef LAST_PHASE
#define LAST_PHASE 99
#endif
#ifndef PHASE_MASK
#define PHASE_MASK 0xFFFFFFFFu
#endif
#ifndef DOUBLE_MASK
#define DOUBLE_MASK 0u
#endif
#define PH(k, ...) do { if constexpr ((PHASE_MASK >> (k)) & 1u) { NEWFRAME(); __VA_ARGS__ if constexpr ((DOUBLE_MASK >> (k)) & 1u) { NEWFRAME(); __VA_ARGS__ } } } while (0)
__global__ void __launch_bounds__(NTHR, 2) fwd_kernel(Args args) {
    extern __shared__ __attribute__((aligned(16))) unsigned char lds_raw[];
#define NEWFRAME() do { int t_ = threadIdx.x; asm volatile("" : "+v"(t_)); F.tid = t_; F.lane = t_ & 63; F.wave = __builtin_amdgcn_readfirstlane(t_ >> 6); } while (0)
    Frame F;
    F.lds = (LAS unsigned char*)lds_raw; F.wg = blockIdx.x; F.G = gridDim.x;
    F.a = &args; F.out = args.out; F.ws = args.ws;
    NEWFRAME();
    volatile LAS unsigned* MISC = (volatile LAS unsigned*)(F.lds + MISC_OFF);
    if (F.tid < 32) MISC[F.tid] = 0u;
    __syncthreads();
    unsigned* ctl = (unsigned*)(F.ws + WS_CTL);
    XcdBarrier bar = xcd_barrier_post(ctl + CW_BAR, MISC + 8);
    LAS unsigned char* stage = F.lds;
    const LAS unsigned short* rowtab = (const LAS unsigned short*)(F.lds + ROWTAB_OFF);

    PH(0, p0_prologue(F););
    xcd_barrier(bar);
    if (LAST_PHASE < 1) return;
    PH(1, { pg8::StaticOrder S; S.init(M / 256, WIN8_HI - WIN8_LO, F.G, F.wg, WGM_IN);
      BWin<false> bs{(const char*)(F.ws + WS_WIN), (size_t)256 * 2048 * 2};
      EpiIn<false> E{(bf16_t*)(F.ws + WS_Q), (bf16_t*)(F.ws + WS_K), (bf16_t*)(F.ws + WS_V), (bf16_t*)(F.ws + WS_QI), (bf16_t*)(F.ws + WS_KI), (bf16_t*)(F.ws + WS_GB), (bf16_t*)(F.ws + WS_CU), (bf16_t*)(F.ws + WS_SGA), (bf16_t*)(F.ws + WS_SGB), (float*)(F.ws + WS_WI)};
      pg8::gemm_phase<EpiIn<false>, BWin<false>, false>(stage, (const bf16_t*)(F.ws + WS_HB), 2048, S, bs, E, rowtab); });
    __syncthreads();
    PH(18, { pg8::StaticOrder S; S.init(M / 256, NIN_TILES - (WIN8_HI - WIN8_LO), F.G, F.wg, WGM_IN);
      BWin<true> bs{(const char*)(F.ws + WS_WIN8), (size_t)256 * 2048};
      EpiIn<true> E{(bf16_t*)(F.ws + WS_Q), (bf16_t*)(F.ws + WS_K), (bf16_t*)(F.ws + WS_V), (bf16_t*)(F.ws + WS_QI), (bf16_t*)(F.ws + WS_KI), (bf16_t*)(F.ws + WS_GB), (bf16_t*)(F.ws + WS_CU), (bf16_t*)(F.ws + WS_SGA), (bf16_t*)(F.ws + WS_SGB), (float*)(F.ws + WS_WI)};
      pg8::gemm_phase<EpiIn<true>, BWin<true>, false>(stage, (const bf16_t*)(F.ws + WS_HB8), 1024, S, bs, E, rowtab); });
    xcd_barrier(bar);
    if (LAST_PHASE < 2) return;
    PH(2, conv_phase(F););
    PH(3, indexer_phase(F););
    asm volatile("s_waitcnt vmcnt(0)" ::: "memory"); __syncthreads();
    PH(4, select_phase(F););
    xcd_barrier(bar);
    if (LAST_PHASE < 4) return;
    PH(6, attention_phase(F););
    xcd_barrier(bar);
#ifdef SELFCHECK
    NEWFRAME(); selfcheck_phase(F.ws, F.inp(I_RELB), ctl, F.wg, F.wave, F.lane, F.lds);
    xcd_barrier(bar);
#endif
    if (LAST_PHASE < 5) return;
    PH(5, { pg8::StaticOrder S; S.init(M / 256, 8, F.G, F.wg, WGM_N8);
      BPlain bs{(const char*)(F.ws + WS_WB), (size_t)256 * 1024};
      EpiGate<false, 4> E{(const bf16_t*)(F.ws + WS_SGB), nullptr, (bf16_t*)(F.ws + WS_T2)};
      pg8::gemm_phase<EpiGate<false, 4>, BPlain, false>(stage, (const bf16_t*)(F.ws + WS_GB8), 512, S, bs, E, rowtab); });
    asm volatile("s_waitcnt vmcnt(0)" ::: "memory"); __syncthreads();
    PH(7, { pg8::StaticOrder S; S.init(M / 256, 8, F.G, F.wg, WGM_N8);
      BPlain bs{(const char*)(F.ws + WS_WA), (size_t)256 * 1024};
      EpiGate<true, 8> E{(const bf16_t*)(F.ws + WS_SGA), (const bf16_t*)(F.ws + WS_T2), (bf16_t*)(F.ws + WS_T2)};
      pg8::gemm_phase<EpiGate<true, 8>, BPlain, false>(stage, (const bf16_t*)(F.ws + WS_ATT), 512, S, bs, E, rowtab); });
    xcd_barrier(bar);
    if (LAST_PHASE < 6) return;
    PH(8, { pg8::StaticOrder S; S.init(M / 256, 8, F.G, F.wg, WGM_N8);
      BPlain bs{(const char*)(F.ws + WS_WO), (size_t)256 * 2048 * 2};
      EpiY1 E{F.inp(I_X), (const float*)(F.ws + WS_STATS), (const float*)(F.ws + WS_STATS) + M, F.inp(I_LNG), F.inp(I_LNB), (float*)(F.ws + WS_Y1)};
      pg8::gemm_phase<EpiY1, BPlain, false>(stage, (const bf16_t*)(F.ws + WS_T2), 2048, S, bs, E, rowtab); });
    xcd_barrier(bar);
    if (LAST_PHASE < 7) return;
    PH(9, ln1_router_phase(F););
    PH(10, { pg8::StaticOrder S; S.init(M / 256, 8, F.G, F.wg, WGM_N8);
      BPlain bs{(const char*)(F.ws + WS_WPP), (size_t)256 * 256 * 2};
      EpiPlain E{(bf16_t*)(F.ws + WS_PLE)};
      int kpp = 256; asm volatile("" : "+s"(kpp));
      pg8::gemm_phase<EpiPlain, BPlain, false>(stage, (const bf16_t*)(F.ws + WS_PB), kpp, S, bs, E, rowtab); });
    xcd_barrier(bar);
    if (LAST_PHASE < 8) return;
    PH(12, moe_assign_phase(F););
    { const bool gemm_first = ((F.wg >> 3) & 1) != 0;
      if (!gemm_first) { PH(11, moe_w1_convert(F);); __syncthreads(); }
      PH(13, { pg8::StaticOrder S; S.init(M / 256, 8, F.G, F.wg, WGM_N8);
        BPlain bs{(const char*)(F.ws + WS_WPG), (size_t)256 * 2048};
        EpiPle E{(bf16_t*)(F.ws + WS_PLE)};
        pg8::gemm_phase<EpiPle, BPlain, false>(stage, (const bf16_t*)(F.ws + WS_H1F), 1024, S, bs, E, rowtab); });
      __syncthreads();
      if (gemm_first) { PH(11, moe_w1_convert(F);); } }
    xcd_barrier(bar);
    if (LAST_PHASE < 9) return;
    const int* EI = (const int*)(F.ws + WS_EXPINFO);
    const int nblk = EI[0];
    const bool gemm_first9 = ((F.wg >> 3) & 1) != 0;
    if (!gemm_first9) { PH(17, moe_w2_convert(F);); __syncthreads(); }
    PH(14, { pg8::StaticOrder S; S.init(nblk, 16, F.G, F.wg, WGM_G1);
      { LAS unsigned short* rt = (LAS unsigned short*)(F.lds + ROWTAB_OFF); const int* ROWTOK = (const int*)(F.ws + WS_ROWTOK); pg8::Unit u;
        for (int i = 0; i < 34 && S.next(i, u); ++i) if (F.tid < 256) rt[i * 256 + F.tid] = (unsigned short)ROWTOK[u.pm * 256 + F.tid]; }
      __syncthreads();
      BExpert bs{(const char*)(F.ws + WS_W1), (size_t)4096 * 2048, (size_t)256 * 2048, EI + 64};
      EpiAct E{F.inp(I_BG), F.inp(I_BU), EI + 64, F.ws + WS_ACT};
      pg8::gemm_phase<EpiAct, BExpert, true>(stage, (const bf16_t*)(F.ws + WS_H1F), 1024, S, bs, E, rowtab); });
    if (gemm_first9) { __syncthreads(); PH(17, moe_w2_convert(F);); }
    xcd_barrier(bar);
    if (LAST_PHASE < 10) return;
    PH(15, { pg8::StaticOrder S; S.init(nblk, 8, F.G, F.wg, WGM_G2);
      BExpert bs{(const char*)(F.ws + WS_W2), (size_t)2048 * 2048, (size_t)256 * 2048, EI + 64};
      EpiDown E{F.inp(I_BD), EI + 64, (const float*)(F.ws + WS_ROWW), F.ws + WS_OW};
      pg8::gemm_phase<EpiDown, BExpert, false>(stage, (const bf16_t*)(F.ws + WS_ACT), 1024, S, bs, E, rowtab); });
    xcd_barrier(bar);
    if (LAST_PHASE < 11) return;
    const bool poison = __hip_atomic_load(ctl + CW_BAR + XB_TMO, RLX_AGENT) != 0u;
    float oscale = 1.0f;
#ifdef SELFCHECK
    { const float eatt = __uint_as_float(__hip_atomic_load(ctl + CW_EATT, RLX_AGENT)), esel = __uint_as_float(__hip_atomic_load(ctl + CW_ESEL, RLX_AGENT)); const unsigned ecnt = __hip_atomic_load(ctl + CW_ECNT, RLX_AGENT);
      float X = 0.1f + fminf(SELFCHECK == 1 ? eatt : esel, 0.8f); if (ecnt) X += 10.f; oscale = 1.0f + X; }
#endif
    PH(16, final_phase(F, poison, oscale););
}

extern "C" void kernel_launch(void* const* d_in, const int* in_sizes, int n_in, void* d_out, int out_size, void* d_ws, size_t ws_size, hipStream_t stream) {
    static int ready = 0;
    if (ready == 0) {
        if (n_in != 24 || in_sizes[0] != M * D || out_size != M * D || ws_size < WS_END) {
            fprintf(stderr, "kernel_launch: built for 24 inputs, x/out of %d floats, >= %zu bytes of workspace; got n_in %d in0 %d out %d ws %zu\n", M * D, (size_t)WS_END, n_in, n_in > 0 ? in_sizes[0] : -1, out_size, ws_size);
            ready = -1; return; }
        int dev = 0, cus = 0, per_cu = 0;
        if (hipGetDevice(&dev) != hipSuccess || hipDeviceGetAttribute(&cus, hipDeviceAttributeMultiprocessorCount, dev) != hipSuccess) { ready = -1; return; }
        if (hipFuncSetAttribute((const void*)fwd_kernel, hipFuncAttributeMaxDynamicSharedMemorySize, LDS_BYTES) != hipSuccess) { fprintf(stderr, "kernel_launch: hipFuncSetAttribute(%d) failed\n", LDS_BYTES); ready = -1; return; }
        if (hipOccupancyMaxActiveBlocksPerMultiprocessor(&per_cu, (const void*)fwd_kernel, NTHR, LDS_BYTES) != hipSuccess || per_cu < 1) fprintf(stderr, "kernel_launch: occupancy query says %d\n", per_cu);
        (void)hipGetLastError();
        if (cus < GRID) { fprintf(stderr, "kernel_launch: %d CUs < %d workgroups: not resident, nothing launched\n", cus, GRID); ready = -1; return; }
        ready = 1;
    }
    if (ready < 0) return;
    if (hipMemsetAsync((char*)d_ws + WS_CTL, 0, CTL_ZERO_BYTES, stream) != hipSuccess) return;
    Args a{};
    for (int i = 0; i < 24; ++i) a.in[i] = (const float*)d_in[i];
    a.out = (float*)d_out; a.ws = (unsigned char*)d_ws;
    hipLaunchKernelGGL(fwd_kernel, dim3(GRID), dim3(NTHR), LDS_BYTES, stream, a);
}
```
